# Optimizing an MI355X kernel written in HIP

```python
import math
import jax, jax.numpy as jnp
from jax import lax
import numpy as np

D_MODEL = 2048
BATCH = 2
SEQ = 4096
DEPTH = 4

N_MIXERS = 2
POOL_WINDOWS = (2, 4, 8, 16)
N_POOL_GROUPS = len(POOL_WINDOWS)
POOL_GROUP = D_MODEL // N_POOL_GROUPS
RET_HEADS = 8
RET_QK_DIM = D_MODEL
RET_V_DIM = 2 * D_MODEL
RET_HEAD_QK = RET_QK_DIM // RET_HEADS
RET_HEAD_V = RET_V_DIM // RET_HEADS
RET_CHUNK = 128
ROPE_BASE = 10000.0
D_FF = 4 * D_MODEL
N_POOL_LAYERS = (DEPTH + 1) // 2
N_RET_LAYERS = DEPTH // 2
EPS = 1e-6
ADA_SCALE = 0.5

kernel_name = 'hybrid_pool_retention_adaln_trunk'


def rmsnorm(x, g):
    xf = x.astype(jnp.float32)
    y = xf * lax.rsqrt(jnp.mean(xf * xf, axis=-1, keepdims=True) + EPS)
    return (y * g.astype(jnp.float32)).astype(x.dtype)


def modulate(h, shift, scale):
    return h * (1 + scale[:, None, :]) + shift[:, None, :]


def pool_mixer(h, w_grp, ls):
    B, S, D = h.shape
    hf = h.astype(jnp.float32)
    cs = jnp.concatenate([jnp.zeros((B, 1, D), jnp.float32), jnp.cumsum(hf, axis=1)], axis=1)
    t = jnp.arange(S)
    outs = []
    for gi, w in enumerate(POOL_WINDOWS):
        lo_c, hi_c = gi * POOL_GROUP, (gi + 1) * POOL_GROUP
        cs_g = cs[:, :, lo_c:hi_c]
        lo = jnp.maximum(t + 1 - w, 0)
        cnt = (t + 1 - lo).astype(jnp.float32)
        mean = (cs_g[:, 1:] - cs_g[:, lo]) / cnt[None, :, None]
        outs.append(mean - hf[:, :, lo_c:hi_c])
    p = jnp.stack(outs, axis=2).astype(h.dtype)
    y = jnp.einsum('bsgc,gcd->bsgd', p, w_grp).reshape(B, S, D)
    return y * ls


def rotary(x, pos):
    d = x.shape[-1]
    inv = ROPE_BASE ** (-jnp.arange(0, d, 2, dtype=jnp.float32) / d)
    ang = pos.astype(jnp.float32)[:, None] * inv[None, :]
    cos = jnp.cos(ang)[None, :, None, :]
    sin = jnp.sin(ang)[None, :, None, :]
    x1, x2 = x[..., 0::2], x[..., 1::2]
    return jnp.stack([x1 * cos - x2 * sin, x1 * sin + x2 * cos], axis=-1).reshape(x.shape)


def retention(h, w_in, w_out):
    B, S, _ = h.shape
    H, dk, dv, C = RET_HEADS, RET_HEAD_QK, RET_HEAD_V, RET_CHUNK
    n = S // C
    proj = h @ w_in
    q, k, v, g = jnp.split(proj, [RET_QK_DIM, 2 * RET_QK_DIM, 2 * RET_QK_DIM + RET_V_DIM], axis=-1)
    pos = jnp.arange(S)
    q = rotary(q.reshape(B, S, H, dk).astype(jnp.float32), pos)
    k = rotary(k.reshape(B, S, H, dk).astype(jnp.float32), pos) * (dk ** -0.5)
    v = v.reshape(B, S, H, dv).astype(jnp.float32)

    gamma = 1.0 - 2.0 ** (-5.0 - jnp.arange(H, dtype=jnp.float32))
    log_g = jnp.log(gamma)
    j = jnp.arange(C, dtype=jnp.float32)
    diff = j[:, None] - j[None, :]
    intra = jnp.where(diff[None] >= 0, jnp.exp(jnp.maximum(diff, 0.0)[None] * log_g[:, None, None]), 0.0)
    q_dec = jnp.exp((j[None, :] + 1.0) * log_g[:, None])[None, :, :, None]
    k_dec = jnp.exp((C - 1.0 - j[None, :]) * log_g[:, None])[None, :, :, None]
    chunk_dec = jnp.exp(C * log_g)[None, :, None, None]

    def to_chunks(a):
        return a.reshape(B, n, C, H, a.shape[-1]).transpose(1, 0, 3, 2, 4)

    def step(state, inp):
        qc, kc, vc = inp
        scores = jnp.einsum('bhid,bhjd->bhij', qc, kc) * intra[None]
        inner = jnp.einsum('bhij,bhje->bhie', scores, vc)
        cross = jnp.einsum('bhid,bhde->bhie', qc * q_dec, state)
        new_state = chunk_dec * state + jnp.einsum('bhjd,bhje->bhde', kc * k_dec, vc)
        return new_state, inner + cross

    state0 = jnp.zeros((B, H, dk, dv), jnp.float32)
    _, y = lax.scan(step, state0, (to_chunks(q), to_chunks(k), to_chunks(v)))
    y = y.transpose(1, 0, 3, 2, 4).reshape(B, S, H, dv)
    mu = jnp.mean(y, axis=-1, keepdims=True)
    var = jnp.mean((y - mu) ** 2, axis=-1, keepdims=True)
    y = ((y - mu) * lax.rsqrt(var + EPS)).reshape(B, S, RET_V_DIM).astype(h.dtype)
    return (jax.nn.silu(g) * y) @ w_out


def sq_relu_mlp(h, w1, w2):
    a = jax.nn.relu(h @ w1)
    return (a * a) @ w2


def setup_inputs(seed: int = 0) -> dict:
    key = jax.random.key(seed)
    ks = jax.random.split(key, 13)
    D = D_MODEL
    nrm = jax.random.normal
    x = nrm(ks[0], (BATCH, SEQ, D), jnp.float32)
    c = nrm(ks[1], (BATCH, D), jnp.float32)
    ada_w = nrm(ks[2], (DEPTH, 2, D, 3 * D), jnp.float32) * (ADA_SCALE * D ** -0.5)
    ada_b = nrm(ks[3], (DEPTH, 2, 3 * D), jnp.float32) * 0.02
    norm_g = 1.0 + 0.05 * nrm(ks[4], (DEPTH, 2, D), jnp.float32)
    pool_w = nrm(ks[5], (N_POOL_LAYERS, N_POOL_GROUPS, POOL_GROUP, POOL_GROUP), jnp.float32) * POOL_GROUP ** -0.5
    pool_scale = 1.0 + 0.1 * nrm(ks[6], (N_POOL_LAYERS, D), jnp.float32)
    ret_w_in = nrm(ks[7], (N_RET_LAYERS, D, 2 * RET_QK_DIM + 2 * RET_V_DIM), jnp.float32) * D ** -0.5
    ret_w_out = nrm(ks[8], (N_RET_LAYERS, RET_V_DIM, D), jnp.float32) * RET_V_DIM ** -0.5
    mlp_w1 = nrm(ks[9], (DEPTH, D, D_FF), jnp.float32) * D ** -0.5
    mlp_w2 = nrm(ks[10], (DEPTH, D_FF, D), jnp.float32) * D_FF ** -0.5
    final_g = 1.0 + 0.05 * nrm(ks[11], (D,), jnp.float32)
    return {'x': x, 'c': c, 'ada_w': ada_w, 'ada_b': ada_b, 'norm_g': norm_g,
            'pool_w': pool_w, 'pool_scale': pool_scale, 'ret_w_in': ret_w_in, 'ret_w_out': ret_w_out,
            'mlp_w1': mlp_w1, 'mlp_w2': mlp_w2, 'final_g': final_g}


def reference(x, c, ada_w, ada_b, norm_g, pool_w, pool_scale, ret_w_in, ret_w_out, mlp_w1, mlp_w2, final_g):
    cond = jax.nn.silu(c)
    for i in range(DEPTH):
        mod = jnp.einsum('bd,sdk->bsk', cond, ada_w[i]) + ada_b[i]
        shift_t, scale_t, gate_t = jnp.split(mod[:, 0], 3, axis=-1)
        shift_m, scale_m, gate_m = jnp.split(mod[:, 1], 3, axis=-1)
        h = modulate(rmsnorm(x, norm_g[i, 0]), shift_t, scale_t)
        if i % N_MIXERS == 0:
            y = pool_mixer(h, pool_w[i // N_MIXERS], pool_scale[i // N_MIXERS])
        else:
            y = retention(h, ret_w_in[i // N_MIXERS], ret_w_out[i // N_MIXERS])
        x = x + gate_t[:, None, :] * y
        h = modulate(rmsnorm(x, norm_g[i, 1]), shift_m, scale_m)
        x = x + gate_m[:, None, :] * sq_relu_mlp(h, mlp_w1[i], mlp_w2[i])
    return rmsnorm(x, final_g)
```

```cpp
#include <hip/hip_runtime.h>
#include <cstdio>
#include <cstdint>

#ifndef MK_PER_PHASE
#define MK_PER_PHASE 1
#endif

namespace pg8 {
#define PG8_LAS __attribute__((address_space(3)))
typedef unsigned short bf16_t;
typedef short bf16x8 __attribute__((ext_vector_type(8)));
typedef float f32x4 __attribute__((ext_vector_type(4)));
typedef unsigned u32x4 __attribute__((ext_vector_type(4)));
constexpr int BM = 256, BK = 64, HALF = 128, HTB = HALF * BK * 2  , STAGE_BYTES = 8 * HTB, NXCD = 8, WGM = 8;

__host__ __device__ __forceinline__ int lds_byte(int r, int c) { const int st = (r >> 4) * 2 + (c >> 5), rr = r & 15, cc = c & 31, ob = rr * 64 + cc * 2; return st * 1024 + (ob ^ (((ob >> 9) & 1) << 5)); }
__host__ __device__ __forceinline__ void stage_rc(int b, int& R, int& C) { const int st = b / 1024, sb = b % 1024, swz = sb ^ (((sb >> 9) & 1) << 5); R = (st >> 1) * 16 + swz / 64; C = (st & 1) * 32 + (swz % 64) / 2; }
__host__ __device__ __forceinline__ int perm32(int rho) { const int n = rho >> 4, i = rho & 15; return 8 * (i >> 2) + 4 * n + (i & 3); }

struct Unit { int pm, pn; };
struct Gemm { const bf16_t* A; const bf16_t* Bt; int M, N, K, lda, ldb, grp_shift, grp_koff; };

struct StaticOrder {
    int nM, nN, nwg, G, c;
    __host__ __device__ void init(int M, int N, int G_, int c_) { nM = M / BM; nN = N / BM; nwg = nM * nN; G = G_; c = c_; }
    __host__ __device__ bool next(int i, Unit& u) const {
        const long L = (long)i * G + c; if (L >= nwg) return false;
        int wgid = (int)L; { const int q = nwg / NXCD, r = nwg % NXCD, xcd = wgid % NXCD, off = wgid / NXCD; wgid = (xcd < r ? xcd * (q + 1) : r * (q + 1) + (xcd - r) * q) + off; }
        const int nig = WGM * nN, gid = wgid / nig, fm = gid * WGM, gsz = (nM - fm) < WGM ? (nM - fm) : WGM;
        u.pm = fm + ((wgid % nig) % gsz); u.pn = (wgid % nig) / gsz; return true;
    }
    __device__ __forceinline__ void a_ready(const Unit&) const {}
    __device__ __forceinline__ void done(const Unit&) const {}
};

__device__ __forceinline__ unsigned cvt_pk_bf16(float lo, float hi) { unsigned r; asm volatile("v_cvt_pk_bf16_f32 %0, %1, %2" : "=v"(r) : "v"(lo), "v"(hi)); return r; }

template <class Epi, class Sched, bool ALIGN_EPI = false, bool SP2 = false>
__device__ __forceinline__ void gemm_phase(PG8_LAS unsigned char* lds, const Gemm g, const Sched& S, const Epi& E) {
    int tid_ = threadIdx.x; asm volatile("" : "+v"(tid_));
    const int tid = tid_, wid = __builtin_amdgcn_readfirstlane(tid >> 6), lane = tid & 63, wr = wid >> 2, wc = wid & 3, fr = lane & 15, fq = lane >> 4;
    const int K = g.K, nt = K / BK;
    unsigned voffA[2], voffB[2];
#pragma unroll
    for (int i = 0; i < 2; ++i) { int R, C; stage_rc(tid * 16 + i * 8192, R, C); const int Rb = Epi::PERM ? ((R & ~31) + perm32(R & 31)) : R;
        voffA[i] = (unsigned)(R * g.lda + C) * 2u; voffB[i] = (unsigned)(Rb * g.ldb + C) * 2u; }
    const size_t kstep = (size_t)(BK * 2);
    const size_t hstepA = (size_t)HALF * g.lda * 2, hstepB = (size_t)HALF * g.ldb * 2;
    const size_t tstepA = 2 * hstepA, tstepB = 2 * hstepB;
    const unsigned ldsw = (unsigned)wid * 1024u;
    const int aoff = lds_byte(wr * 64 + fr, fq * 8), boff = lds_byte(wc * 32 + fr, fq * 8);
#define PG8_APTR(u) ((const char*)g.A + (size_t)(u).pm * tstepA + (size_t)(((u).pn >> g.grp_shift) * g.grp_koff) * 2)
#define PG8_BPTR(u) ((const char*)g.Bt + (size_t)(u).pn * tstepB)
#define PG8_SA(b, h) (((b) * 2 + (h)) * HTB)
#define PG8_SB(b, h) ((4 + (b) * 2 + (h)) * HTB)
#define PG8_STAGE(bufoff, gbase, voff) do { _Pragma("unroll") for (int _i = 0; _i < 2; ++_i) \
        __builtin_amdgcn_global_load_lds((const unsigned*)((const char*)(gbase) + (voff)[_i]), (PG8_LAS unsigned*)(lds + (bufoff) + ldsw + _i * 8192), 16, 0, 0); } while (0)
#define PG8_LDA(dst, b, h) do { _Pragma("unroll") for (int m = 0; m < 4; ++m) _Pragma("unroll") for (int k = 0; k < 2; ++k) dst[m][k] = *(const PG8_LAS bf16x8*)(lds + PG8_SA(b, h) + aoff + m * 2048 + k * 1024); } while (0)
#define PG8_LDB(dst, b, h) do { _Pragma("unroll") for (int n = 0; n < 2; ++n) _Pragma("unroll") for (int k = 0; k < 2; ++k) dst[n][k] = *(const PG8_LAS bf16x8*)(lds + PG8_SB(b, h) + boff + n * 2048 + k * 1024); } while (0)
#define PG8_MMA(ai, bj, At, Bt) do { __builtin_amdgcn_s_setprio(1); _Pragma("unroll") for (int m = 0; m < 4; ++m) _Pragma("unroll") for (int n = 0; n < 2; ++n) _Pragma("unroll") for (int k = 0; k < 2; ++k) \
        acc[ai][bj][m][n] = __builtin_amdgcn_mfma_f32_16x16x32_bf16(Bt[n][k], At[m][k], acc[ai][bj][m][n], 0, 0, 0); __builtin_amdgcn_s_setprio(0); } while (0)
#define PG8_WAIT_V(n) asm volatile("s_waitcnt vmcnt(" #n ")" ::: "memory")
#define PG8_WAIT_L(n) asm volatile("s_waitcnt lgkmcnt(" #n ")" ::: "memory")
#define PG8_BAR __builtin_amdgcn_s_barrier()
#define PG8_SCHED __builtin_amdgcn_sched_barrier(0)
    Unit cur, nxt; int ui = 0;
    if (!S.next(0, cur)) return;
    f32x4 acc[2][2][4][2];
#pragma unroll
    for (int a = 0; a < 2; ++a)
#pragma unroll
        for (int b = 0; b < 2; ++b)
#pragma unroll
            for (int m = 0; m < 4; ++m)
#pragma unroll
                for (int n = 0; n < 2; ++n) acc[a][b][m][n] = (f32x4){0.f, 0.f, 0.f, 0.f};
    bf16x8 At[4][2], B0[2][2], B1[2][2];
    const char* cA = PG8_APTR(cur); const char* cB = PG8_BPTR(cur);
    S.a_ready(cur);
    if constexpr (SP2) {
        PG8_STAGE(PG8_SB(0, 0), cB, voffB); PG8_STAGE(PG8_SB(0, 1), cB + hstepB, voffB); PG8_STAGE(PG8_SA(0, 0), cA, voffA); PG8_STAGE(PG8_SA(0, 1), cA + hstepA, voffA);
        if (wr == 1) PG8_BAR;
        PG8_WAIT_V(2); PG8_BAR;
        PG8_STAGE(PG8_SB(1, 0), cB + kstep, voffB); PG8_STAGE(PG8_SA(1, 0), cA + kstep, voffA); PG8_STAGE(PG8_SB(1, 1), cB + hstepB + kstep, voffB);
        PG8_WAIT_V(6); PG8_BAR;
    } else {
        PG8_STAGE(PG8_SB(0, 0), cB, voffB); PG8_STAGE(PG8_SA(0, 0), cA, voffA); PG8_STAGE(PG8_SB(0, 1), cB + hstepB, voffB); PG8_STAGE(PG8_SA(0, 1), cA + hstepA, voffA);
        if (wr == 1) PG8_BAR;
        PG8_WAIT_V(4); PG8_BAR;
        PG8_STAGE(PG8_SB(1, 0), cB + kstep, voffB); PG8_STAGE(PG8_SA(1, 0), cA + kstep, voffA); PG8_STAGE(PG8_SB(1, 1), cB + hstepB + kstep, voffB);
        PG8_WAIT_V(6); PG8_BAR;
    }
    for (;;) {
        const bool has_next = S.next(ui + 1, nxt);
        const char* nA = has_next ? PG8_APTR(nxt) : cA; const char* nB = has_next ? PG8_BPTR(nxt) : cB;
        for (int t = 0; t < nt; t += 2) {
            const bool last = (t == nt - 2);
            const char* a1 = cA + (size_t)(t + 1) * kstep;
            const char* a2 = last ? nA : cA + (size_t)(t + 2) * kstep; const char* b2 = last ? nB : cB + (size_t)(t + 2) * kstep;
            const char* a3 = a2 + kstep; const char* b3 = b2 + kstep;
            if (last && has_next) S.a_ready(nxt);
            if constexpr (SP2) {
            PG8_LDB(B0, 0, 0); PG8_LDB(B1, 0, 1); PG8_SCHED; PG8_LDA(At, 0, 0); PG8_STAGE(PG8_SA(1, 1), a1 + hstepA, voffA);
            PG8_WAIT_V(8); PG8_WAIT_L(0); PG8_BAR; PG8_MMA(0, 0, At, B0); PG8_MMA(0, 1, At, B1); PG8_BAR; PG8_SCHED;
            PG8_LDA(At, 0, 1); PG8_STAGE(PG8_SB(0, 0), b2, voffB); PG8_STAGE(PG8_SB(0, 1), b2 + hstepB, voffB); PG8_STAGE(PG8_SA(0, 0), a2, voffA);
            PG8_WAIT_V(8); PG8_WAIT_L(0); PG8_BAR; PG8_MMA(1, 0, At, B0); PG8_MMA(1, 1, At, B1); PG8_BAR; PG8_SCHED;
            PG8_LDB(B0, 1, 0); PG8_LDB(B1, 1, 1); PG8_SCHED; PG8_LDA(At, 1, 0); PG8_STAGE(PG8_SA(0, 1), a2 + hstepA, voffA);
            PG8_WAIT_V(8); PG8_WAIT_L(0); PG8_BAR; PG8_MMA(0, 0, At, B0); PG8_MMA(0, 1, At, B1); PG8_BAR; PG8_SCHED;
            PG8_LDA(At, 1, 1); PG8_STAGE(PG8_SB(1, 0), b3, voffB); PG8_STAGE(PG8_SB(1, 1), b3 + hstepB, voffB); PG8_STAGE(PG8_SA(1, 0), a3, voffA);
            PG8_WAIT_V(8); PG8_WAIT_L(0); PG8_BAR; PG8_MMA(1, 0, At, B0); PG8_MMA(1, 1, At, B1); PG8_BAR; PG8_SCHED;
            } else {
            PG8_LDB(B0, 0, 0); PG8_SCHED; PG8_LDA(At, 0, 0); PG8_STAGE(PG8_SA(1, 1), a1 + hstepA, voffA);
            PG8_WAIT_L(8); PG8_BAR; PG8_WAIT_L(0); PG8_MMA(0, 0, At, B0); PG8_BAR; PG8_SCHED;
            PG8_LDB(B1, 0, 1); PG8_STAGE(PG8_SB(0, 0), b2, voffB);
            PG8_BAR; PG8_WAIT_L(0); PG8_MMA(0, 1, At, B1); PG8_BAR;
            PG8_LDA(At, 0, 1); PG8_STAGE(PG8_SA(0, 0), a2, voffA);
            PG8_BAR; PG8_WAIT_L(0); PG8_MMA(1, 0, At, B0); PG8_BAR; PG8_SCHED;
            PG8_STAGE(PG8_SB(0, 1), b2 + hstepB, voffB);
            PG8_WAIT_V(6); PG8_BAR; PG8_MMA(1, 1, At, B1); PG8_BAR;
            PG8_LDB(B0, 1, 0); PG8_SCHED; PG8_LDA(At, 1, 0); PG8_STAGE(PG8_SA(0, 1), a2 + hstepA, voffA);
            PG8_WAIT_L(8); PG8_BAR; PG8_WAIT_L(0); PG8_MMA(0, 0, At, B0); PG8_BAR; PG8_SCHED;
            PG8_LDB(B1, 1, 1); PG8_STAGE(PG8_SB(1, 0), b3, voffB);
            PG8_BAR; PG8_WAIT_L(0); PG8_MMA(0, 1, At, B1); PG8_BAR;
            PG8_LDA(At, 1, 1); PG8_STAGE(PG8_SA(1, 0), a3, voffA);
            PG8_BAR; PG8_WAIT_L(0); PG8_MMA(1, 0, At, B0); PG8_BAR; PG8_SCHED;
            PG8_STAGE(PG8_SB(1, 1), b3 + hstepB, voffB);
            PG8_WAIT_V(6); PG8_BAR; PG8_MMA(1, 1, At, B1); PG8_BAR;
            }
        }
        if constexpr (ALIGN_EPI) { if (wr == 0) PG8_BAR; }
        E(acc, cur, wr, wc, fr, fq);
        if (!has_next) break;
#pragma unroll
        for (int a = 0; a < 2; ++a)
#pragma unroll
            for (int b = 0; b < 2; ++b)
#pragma unroll
                for (int m = 0; m < 4; ++m)
#pragma unroll
                    for (int n = 0; n < 2; ++n) acc[a][b][m][n] = (f32x4){0.f, 0.f, 0.f, 0.f};
        cur = nxt; cA = nA; cB = nB; ++ui;
        if constexpr (ALIGN_EPI) { if (wr == 1) PG8_BAR; }
    }
    PG8_WAIT_V(0);
    if constexpr (!ALIGN_EPI) { if (wr == 0) PG8_BAR; }
    PG8_BAR;
#undef PG8_APTR
#undef PG8_BPTR
#undef PG8_SA
#undef PG8_SB
#undef PG8_STAGE
#undef PG8_LDA
#undef PG8_LDB
#undef PG8_MMA
#undef PG8_WAIT_V
#undef PG8_WAIT_L
#undef PG8_BAR
#undef PG8_SCHED
}
}

constexpr int NWAVES = 8, NTHR = NWAVES * 64;
constexpr int BATCH = 2, SEQ = 4096, D = 2048, DEPTH = 4, M = BATCH * SEQ;
constexpr int NPG = 4, PG = 512;
constexpr int RH = 8, DK = 256, DV = 512, VD = 4096, RC = 128, NCH = SEQ / RC;
constexpr int NPROJ = 2 * D + 2 * VD;
constexpr int FF = 4 * D;
constexpr float EPS = 1e-6f;

constexpr size_t MiB = 1u << 20;
constexpr size_t WS_CTL = 0, CTL_ZERO_BYTES = 64 * 1024;
constexpr size_t WS_MOD = 1 * MiB;
constexpr size_t WS_DEC = 2 * MiB;
constexpr size_t WS_COS = 3 * MiB, WS_SIN = 5 * MiB;
constexpr size_t WS_WPOOL = 8 * MiB;
constexpr size_t WS_WIN = 12 * MiB;
constexpr size_t WS_WOUT = 108 * MiB;
constexpr size_t WS_W1 = 140 * MiB;
constexpr size_t WS_W2 = 268 * MiB;
constexpr size_t WS_H = 396 * MiB;
constexpr size_t WS_U = 428 * MiB;
constexpr size_t WS_QD = 556 * MiB;
constexpr size_t WS_KD = 588 * MiB;
constexpr size_t WS_V = 620 * MiB;
constexpr size_t WS_SG = 684 * MiB;
constexpr size_t WS_Y = 748 * MiB;
constexpr size_t WS_Z = 812 * MiB;
constexpr size_t WS_S = 876 * MiB;
constexpr size_t WS_END = 892 * MiB;
constexpr int CW_BAR = 4096;

constexpr int RING_BYTES = 131072;
constexpr int LDSCTL_OFF = RING_BYTES, MISC_OFF = LDSCTL_OFF + 320;
constexpr int LDS_BYTES = 147456;

#define GAS __attribute__((address_space(1)))
#define LAS __attribute__((address_space(3)))
typedef unsigned short bf16;
typedef unsigned v4u __attribute__((ext_vector_type(4)));
typedef unsigned v2u __attribute__((ext_vector_type(2)));
typedef float f32x4 __attribute__((ext_vector_type(4)));
typedef float f32x2 __attribute__((ext_vector_type(2)));
typedef short bf16x8 __attribute__((ext_vector_type(8)));
typedef short bf16x4 __attribute__((ext_vector_type(4)));
typedef GAS unsigned gu32;
#define RLX_AGENT __ATOMIC_RELAXED, __HIP_MEMORY_SCOPE_AGENT
__device__ __forceinline__ unsigned f2bf(float f) { unsigned u = __builtin_bit_cast(unsigned, f); return (u + 0x7fffu + ((u >> 16) & 1u)) >> 16; }
__device__ __forceinline__ unsigned pk2(float lo, float hi) { return f2bf(lo) | (f2bf(hi) << 16); }
__device__ __forceinline__ float bf2f(unsigned short b) { return __builtin_bit_cast(float, ((unsigned)b) << 16); }
__device__ __forceinline__ float bflo(unsigned w) { return __builtin_bit_cast(float, w << 16); }
__device__ __forceinline__ float bfhi(unsigned w) { return __builtin_bit_cast(float, w & 0xffff0000u); }

#define XB_TMO      128
#define XB_XCNT(j)  (256  + 64 * (j))
#define XB_XSUB(j)  (1280 + 64 * (j))
#define XB_XGEN(j)  (2304 + 64 * (j))
#define XB_TOP      3328
#define XB_TOPGEN   3392
#define XCD_BAR_WORDS 3456
#define XB_SPIN_CAP (1u << 18)
__device__ __forceinline__ unsigned xb_ld(unsigned* p)              { return __hip_atomic_load(p, __ATOMIC_RELAXED, __HIP_MEMORY_SCOPE_AGENT); }
__device__ __forceinline__ unsigned xb_add(unsigned* p, unsigned v) { return __hip_atomic_fetch_add(p, v, __ATOMIC_RELAXED, __HIP_MEMORY_SCOPE_AGENT); }
__device__ __forceinline__ unsigned xb_xcc_id() { return (unsigned)__builtin_amdgcn_s_getreg((3 << 11) | 20) & 0xFu; }
#define XB_SPIN(cond, bar) do { unsigned _sp = 0; while (cond) { __builtin_amdgcn_s_sleep(1); \
    if ((++_sp & 255u) == 0u) { if (xb_ld(&(bar)[XB_TMO])) break; if (_sp > XB_SPIN_CAP) { atomicAdd(&(bar)[XB_TMO], 1u); break; } } } } while (0)
struct XcdBarrier { unsigned* bar; unsigned x; volatile LAS unsigned* st; };
__device__ __forceinline__ XcdBarrier xcd_barrier_post(unsigned* bar, volatile LAS unsigned* st) {
    XcdBarrier b; b.bar = bar; b.x = xb_xcc_id(); b.st = st;
    if (threadIdx.x == 0) (void)xb_add(&bar[XB_XCNT(b.x)], 1u);
    return b;
}
__device__ __forceinline__ void xcd_barrier_complete(unsigned* bar, unsigned x, unsigned& nloc, unsigned& nx) {
    const unsigned G = gridDim.x * gridDim.y * gridDim.z;
    unsigned sum, cnt, mine, sp = 0u;
    for (;;) {
        sum = 0u; cnt = 0u; mine = 0u;
#pragma unroll
        for (unsigned j = 0; j < 16; ++j) { const unsigned c = xb_ld(&bar[XB_XCNT(j)]); sum += c; cnt += (c > 0u) ? 1u : 0u; mine = (j == x) ? c : mine; }
        if (sum == G) break;
        __builtin_amdgcn_s_sleep(1);
        if ((++sp & 255u) == 0u) { if (xb_ld(&bar[XB_TMO])) break; if (sp > XB_SPIN_CAP) { atomicAdd(&bar[XB_TMO], 1u); break; } }
    }
    nloc = mine > 0u ? mine : 1u; nx = cnt > 0u ? cnt : 1u;
}
__device__ __forceinline__ void xcd_barrier(const XcdBarrier& b) {
    asm volatile("s_waitcnt vmcnt(0)" ::: "memory");
    __syncthreads();
    if (threadIdx.x == 0) {
        unsigned* bar = b.bar;
        __builtin_amdgcn_s_waitcnt(0);
        unsigned nloc = b.st[0], nx = b.st[1];
        if (nloc == 0u) { xcd_barrier_complete(bar, b.x, nloc, nx); b.st[0] = nloc; b.st[1] = nx; }
        const unsigned old = xb_add(&bar[XB_XSUB(b.x)], 1u);
        const unsigned gen = old / nloc;
        if (old + 1u == (gen + 1u) * nloc) {
            __builtin_amdgcn_fence(__ATOMIC_RELEASE, "agent");
            asm volatile("s_waitcnt vmcnt(0)" ::: "memory");
            const unsigned og = xb_add(&bar[XB_TOP], 1u);
            const unsigned tg = og / nx;
            if (og + 1u == (tg + 1u) * nx) xb_add(&bar[XB_TOPGEN], 1u);
            else XB_SPIN(xb_ld(&bar[XB_TOPGEN]) == tg, bar);
            __builtin_amdgcn_fence(__ATOMIC_ACQUIRE, "agent");
            xb_add(&bar[XB_XGEN(b.x)], 1u);
            asm volatile("s_waitcnt vmcnt(0)" ::: "memory");
        } else {
            XB_SPIN(xb_ld(&bar[XB_XGEN(b.x)]) == gen, bar);
            __builtin_amdgcn_fence(__ATOMIC_ACQUIRE, "agent");
            asm volatile("s_waitcnt vmcnt(0)" ::: "memory");
        }
    }
    __syncthreads();
}

struct Frame {
    LAS unsigned char* lds;
    int tid, lane, wave, vcu, G;
    unsigned char* ws;
    __device__ __forceinline__ void refresh() { int t = threadIdx.x; asm volatile("" : "+v"(t)); tid = t; lane = t & 63; wave = __builtin_amdgcn_readfirstlane(t >> 6); }
};
__device__ __forceinline__ float wave_sum(float v) {
#pragma unroll
    for (int o = 1; o < 64; o <<= 1) v += __shfl_xor(v, o);
    return v;
}

using pg8::Unit; using pg8::BM; using pg8::HALF; using pg8::bf16_t; using pg8::u32x4; using pg8::cvt_pk_bf16;
struct EpiRes {
    static constexpr bool PERM = false;
    const float* xin; float* xout; const float* gate; int gstride; const float* ls;
    __device__ __forceinline__ void operator()(const f32x4 (&acc)[2][2][4][2], const Unit& u, int wr, int wc, int fr, int fq) const {
        const int row0 = u.pm * BM + wr * 64 + fr, col0 = u.pn * BM + wc * 32 + 4 * fq;
        const int b = (u.pm * BM) / SEQ;
        f32x4 gv[2][2];
#pragma unroll
        for (int bj = 0; bj < 2; ++bj)
#pragma unroll
            for (int n = 0; n < 2; ++n) { const int c = col0 + bj * HALF + n * 16; f32x4 gg = *(const f32x4*)(gate + (size_t)b * gstride + c); if (ls) gg = gg * *(const f32x4*)(ls + c); gv[bj][n] = gg; }
#pragma unroll
        for (int ai = 0; ai < 2; ++ai)
#pragma unroll
            for (int m = 0; m < 4; ++m) { const size_t off = (size_t)(row0 + ai * HALF + m * 16) * D + col0;
#pragma unroll
                for (int bj = 0; bj < 2; ++bj)
#pragma unroll
                    for (int n = 0; n < 2; ++n) { const f32x4 xi = *(const f32x4*)(xin + off + bj * HALF + n * 16); *(f32x4*)(xout + off + bj * HALF + n * 16) = xi + gv[bj][n] * acc[ai][bj][m][n]; }
                if (m & 1) asm volatile("" ::: "memory"); }
    }
};
struct EpiSq {
    static constexpr bool PERM = true;
    bf16_t* O; int ldc;
    __device__ __forceinline__ void operator()(const f32x4 (&acc)[2][2][4][2], const Unit& u, int wr, int wc, int fr, int fq) const {
        const int row0 = u.pm * BM + wr * 64 + fr, col0 = u.pn * BM + wc * 32 + 8 * fq;
#pragma unroll
        for (int ai = 0; ai < 2; ++ai)
#pragma unroll
            for (int m = 0; m < 4; ++m) { bf16_t* rowp = O + (size_t)(row0 + ai * HALF + m * 16) * ldc + col0;
#pragma unroll
                for (int bj = 0; bj < 2; ++bj) { f32x4 v0 = acc[ai][bj][m][0], v1 = acc[ai][bj][m][1];
#pragma unroll
                    for (int j = 0; j < 4; ++j) { const float a0 = fmaxf(v0[j], 0.f), a1 = fmaxf(v1[j], 0.f); v0[j] = a0 * a0; v1[j] = a1 * a1; }
                    u32x4 w; w.x = cvt_pk_bf16(v0[0], v0[1]); w.y = cvt_pk_bf16(v0[2], v0[3]); w.z = cvt_pk_bf16(v1[0], v1[1]); w.w = cvt_pk_bf16(v1[2], v1[3]);
                    *(u32x4*)(rowp + bj * HALF) = w; } }
    }
};
struct EpiProj {
    static constexpr bool PERM = true;
    bf16_t *QD, *KD, *V, *SG; const float *cosT, *sinT, *dec;
    __device__ __forceinline__ void operator()(const f32x4 (&acc)[2][2][4][2], const Unit& u, int wr, int wc, int fr, int fq) const {
        const int row0 = u.pm * BM + wr * 64 + fr, c0 = wc * 32 + 8 * fq;
        if (u.pn < 16) {
            const int h = u.pn & 7; const bool isk = u.pn >= 8;
            bf16_t* base = (isk ? KD : QD) + h * DK + c0;
            const float* dtab = dec + (isk ? 1024 : 0) + h * RC;
#pragma unroll
            for (int ai = 0; ai < 2; ++ai)
#pragma unroll
                for (int m = 0; m < 4; ++m) { const int r = row0 + ai * HALF + m * 16; const int pos = r & (SEQ - 1); const float dc = dtab[r & (RC - 1)];
#pragma unroll
                    for (int bj = 0; bj < 2; ++bj) { const int pi = (c0 + bj * HALF) >> 1;
                        const f32x4 cs = *(const f32x4*)(cosT + (size_t)pos * 128 + pi), sn = *(const f32x4*)(sinT + (size_t)pos * 128 + pi);
                        const f32x4 v0 = acc[ai][bj][m][0], v1 = acc[ai][bj][m][1];
                        const float o0 = (v0[0] * cs[0] - v0[1] * sn[0]) * dc, o1 = (v0[0] * sn[0] + v0[1] * cs[0]) * dc;
                        const float o2 = (v0[2] * cs[1] - v0[3] * sn[1]) * dc, o3 = (v0[2] * sn[1] + v0[3] * cs[1]) * dc;
                        const float o4 = (v1[0] * cs[2] - v1[1] * sn[2]) * dc, o5 = (v1[0] * sn[2] + v1[1] * cs[2]) * dc;
                        const float o6 = (v1[2] * cs[3] - v1[3] * sn[3]) * dc, o7 = (v1[2] * sn[3] + v1[3] * cs[3]) * dc;
                        u32x4 w; w.x = cvt_pk_bf16(o0, o1); w.y = cvt_pk_bf16(o2, o3); w.z = cvt_pk_bf16(o4, o5); w.w = cvt_pk_bf16(o6, o7);
                        *(u32x4*)(base + (size_t)r * D + bj * HALF) = w; }
                    if (m & 1) asm volatile("" ::: "memory"); }
        } else {
            const bool isg = u.pn >= 32;
            bf16_t* base = (isg ? SG : V) + (u.pn - (isg ? 32 : 16)) * BM + c0;
#pragma unroll
            for (int ai = 0; ai < 2; ++ai)
#pragma unroll
                for (int m = 0; m < 4; ++m) { const int r = row0 + ai * HALF + m * 16;
#pragma unroll
                    for (int bj = 0; bj < 2; ++bj) { f32x4 v0 = acc[ai][bj][m][0], v1 = acc[ai][bj][m][1];
                        if (isg) {
#pragma unroll
                            for (int j = 0; j < 4; ++j) { v0[j] = v0[j] * __builtin_amdgcn_rcpf(1.0f + __expf(-v0[j])); v1[j] = v1[j] * __builtin_amdgcn_rcpf(1.0f + __expf(-v1[j])); } }
                        u32x4 w; w.x = cvt_pk_bf16(v0[0], v0[1]); w.y = cvt_pk_bf16(v0[2], v0[3]); w.z = cvt_pk_bf16(v1[0], v1[1]); w.w = cvt_pk_bf16(v1[2], v1[3]);
                        *(u32x4*)(base + (size_t)r * VD + bj * HALF) = w; } }
        }
    }
};

__device__ __forceinline__ void p0_transpose_item(const float* W, int K, int N, bf16* WT, LAS float* scr, int item, int lane) {
    const int nblk = N / 32, kb = item / nblk, nb = item % nblk, k0 = 64 * kb, n0 = 32 * nb;
#pragma unroll 8
    for (int i = 0; i < 32; ++i) { const int kk = 2 * i + (lane >> 5); scr[kk * 33 + (lane & 31)] = W[(size_t)(k0 + kk) * N + n0 + (lane & 31)]; }
    asm volatile("s_waitcnt lgkmcnt(0)" ::: "memory");
    const int c = lane & 7;
#pragma unroll
    for (int j = 0; j < 4; ++j) { const int n = (lane >> 3) + 8 * j; const LAS float* s = scr + (8 * c) * 33 + n;
        v4u o; o.x = pk2(s[0 * 33], s[1 * 33]); o.y = pk2(s[2 * 33], s[3 * 33]); o.z = pk2(s[4 * 33], s[5 * 33]); o.w = pk2(s[6 * 33], s[7 * 33]);
        *(v4u*)(WT + (size_t)(n0 + n) * K + k0 + 8 * c) = o; }
    asm volatile("s_waitcnt lgkmcnt(0)" ::: "memory");
}
struct Inputs { const float *x, *c, *ada_w, *ada_b, *norm_g, *pool_w, *pool_scale, *ret_w_in, *ret_w_out, *mlp_w1, *mlp_w2, *final_g; };

__device__ __forceinline__ void prologue_phase(Frame& F, const Inputs& in) {
    F.refresh();
    LAS float* cond = (LAS float*)(F.lds);
    LAS float* red = (LAS float*)(F.lds + 16384);
    for (int i = F.tid; i < BATCH * D; i += NTHR) { const float cv = in.c[i]; cond[i] = cv / (1.0f + expf(-cv)); }
    __syncthreads();
    float* mod = (float*)(F.ws + WS_MOD);
    for (int it = blockIdx.x; it < 8 * 96; it += F.G) {
        const int is = it / 96, col0 = (it % 96) * 64;
        const float* W = in.ada_w + (size_t)is * D * (3 * D) + col0;
        const int rsub = F.lane >> 4, cq = F.lane & 15, d0 = F.wave * 256;
        f32x4 a0 = {0.f, 0.f, 0.f, 0.f}, a1 = {0.f, 0.f, 0.f, 0.f};
#pragma unroll 8
        for (int rr = 0; rr < 256; rr += 4) { const int d = d0 + rr + rsub; const f32x4 wv = *(const f32x4*)(W + (size_t)d * (3 * D) + 4 * cq);
            const float c0 = cond[d], c1 = cond[D + d]; a0 += wv * c0; a1 += wv * c1; }
#pragma unroll
        for (int j = 0; j < 4; ++j) { a0[j] += __shfl_xor(a0[j], 16); a0[j] += __shfl_xor(a0[j], 32); a1[j] += __shfl_xor(a1[j], 16); a1[j] += __shfl_xor(a1[j], 32); }
        if (rsub == 0) { *(LAS f32x4*)(red + (F.wave * 2 + 0) * 64 + 4 * cq) = a0; *(LAS f32x4*)(red + (F.wave * 2 + 1) * 64 + 4 * cq) = a1; }
        __syncthreads();
        if (F.tid < 128) { const int b = F.tid >> 6, cc = F.tid & 63; float s = 0.f;
#pragma unroll
            for (int w = 0; w < 8; ++w) s += red[(w * 2 + b) * 64 + cc];
            mod[((size_t)is * BATCH + b) * (3 * D) + col0 + cc] = s + in.ada_b[(size_t)is * (3 * D) + col0 + cc]; }
        __syncthreads();
    }
    {
        LAS float* scr = (LAS float*)(F.lds + 32768 + F.wave * 8704);
        const int gw = F.vcu * NWAVES + F.wave, NGW = F.G * NWAVES;
        constexpr int I_P = (PG / 64) * (PG / 32), I_IN = (D / 64) * (NPROJ / 32), I_OUT = (VD / 64) * (D / 32), I_1 = (D / 64) * (FF / 32), I_2 = (FF / 64) * (D / 32);
        constexpr int N_P = 8 * I_P, N_IN = 2 * I_IN, N_OUT = 2 * I_OUT, N_1 = 4 * I_1, N_2 = 4 * I_2;
        for (int it = gw; it < N_P + N_IN + N_OUT + N_1 + N_2; it += NGW) {
            int r = it;
            if (r < N_P) { const int mt = r / I_P; p0_transpose_item(in.pool_w + (size_t)mt * PG * PG, PG, PG, (bf16*)(F.ws + WS_WPOOL) + (size_t)mt * PG * PG, scr, r % I_P, F.lane); continue; } r -= N_P;
            if (r < N_IN) { const int mt = r / I_IN; p0_transpose_item(in.ret_w_in + (size_t)mt * D * NPROJ, D, NPROJ, (bf16*)(F.ws + WS_WIN) + (size_t)mt * D * NPROJ, scr, r % I_IN, F.lane); continue; } r -= N_IN;
            if (r < N_OUT) { const int mt = r / I_OUT; p0_transpose_item(in.ret_w_out + (size_t)mt * VD * D, VD, D, (bf16*)(F.ws + WS_WOUT) + (size_t)mt * VD * D, scr, r % I_OUT, F.lane); continue; } r -= N_OUT;
            if (r < N_1) { const int mt = r / I_1; p0_transpose_item(in.mlp_w1 + (size_t)mt * D * FF, D, FF, (bf16*)(F.ws + WS_W1) + (size_t)mt * D * FF, scr, r % I_1, F.lane); continue; } r -= N_1;
            { const int mt = r / I_2; p0_transpose_item(in.mlp_w2 + (size_t)mt * FF * D, FF, D, (bf16*)(F.ws + WS_W2) + (size_t)mt * FF * D, scr, r % I_2, F.lane); }
        }
    }
    {
        float* cosT = (float*)(F.ws + WS_COS); float* sinT = (float*)(F.ws + WS_SIN);
        const int gt = blockIdx.x * NTHR + F.tid, NGT = F.G * NTHR;
        for (int e = gt; e < SEQ * 128; e += NGT) {
            const int pos = e >> 7, i = e & 127;
            double inv = 1.0, bp = 0.9305720409296989792906463164991290590767;
#pragma unroll
            for (int bit = 0; bit < 7; ++bit) { if ((i >> bit) & 1) inv *= bp; bp *= bp; }
            const double ang = (double)pos * inv;
            const double kq = __builtin_rint(ang * 0.6366197723675814);
            double r = __builtin_fma(-kq, 1.5707963267948966, ang); r = __builtin_fma(-kq, 6.123233995736766e-17, r);
            const double r2 = r * r;
            double sp = -1.0 / 1307674368000.0;
            sp = sp * r2 + 1.0 / 6227020800.0; sp = sp * r2 - 1.0 / 39916800.0; sp = sp * r2 + 1.0 / 362880.0; sp = sp * r2 - 1.0 / 5040.0; sp = sp * r2 + 1.0 / 120.0; sp = sp * r2 - 1.0 / 6.0; sp = sp * r2 + 1.0;
            const double sr = sp * r;
            double cp = 1.0 / 20922789888000.0;
            cp = cp * r2 - 1.0 / 87178291200.0; cp = cp * r2 + 1.0 / 479001600.0; cp = cp * r2 - 1.0 / 3628800.0; cp = cp * r2 + 1.0 / 40320.0; cp = cp * r2 - 1.0 / 720.0; cp = cp * r2 + 1.0 / 24.0; cp = cp * r2 - 0.5; cp = cp * r2 + 1.0;
            const int q = ((int)kq) & 3;
            const double sv = (q == 0) ? sr : (q == 1) ? cp : (q == 2) ? -sr : -cp;
            const double cv = (q == 0) ? cp : (q == 1) ? -sr : (q == 2) ? -cp : sr;
            cosT[e] = (float)cv; sinT[e] = (float)sv;
        }
        if (blockIdx.x == 0 && F.tid < RH) {
            float* dec = (float*)(F.ws + WS_DEC); const int h = F.tid;
            const double gam = 1.0 - __builtin_ldexp(1.0, -5 - h);
            double p = 1.0;
            for (int i = 0; i < RC; ++i) { p *= gam; dec[h * RC + i] = (float)p; }
            const double g128 = p;
            double q = 1.0 / 16.0;
            for (int j = RC - 1; j >= 0; --j) { dec[1024 + h * RC + j] = (float)q; q *= gam; }
            dec[2048 + h] = (float)(1.0 / g128);
            dec[2056 + h] = (float)g128;
        }
    }
}

__device__ __forceinline__ void norm_phase(Frame& F, const float* x, bf16* H, const float* g, const float* modp) {
    F.refresh();
    const int gw = F.vcu * NWAVES + F.wave, NGW = F.G * NWAVES;
    for (int r4 = gw; r4 < M / 4; r4 += NGW) {
        const int b = (4 * r4) / SEQ; const float* mp = modp + (size_t)b * (3 * D);
        f32x4 Gc[8], Sc[8];
#pragma unroll
        for (int j = 0; j < 8; ++j) { const int c = 4 * F.lane + 256 * j; const f32x4 gg = *(const f32x4*)(g + c), sc = *(const f32x4*)(mp + D + c); Gc[j] = gg * (sc + 1.0f); Sc[j] = *(const f32x4*)(mp + c); }
        for (int rr = 0; rr < 4; ++rr) {
            const size_t row = (size_t)4 * r4 + rr; const f32x4* xr = (const f32x4*)(x + row * D) + F.lane;
            f32x4 v[8]; float ss = 0.f;
#pragma unroll
            for (int j = 0; j < 8; ++j) { v[j] = xr[64 * j]; ss += (v[j].x * v[j].x + v[j].y * v[j].y) + (v[j].z * v[j].z + v[j].w * v[j].w); }
            const float rstd = 1.0f / sqrtf(wave_sum(ss) * (1.0f / D) + EPS);
            v2u* o = (v2u*)(H + row * D) + F.lane;
#pragma unroll
            for (int j = 0; j < 8; ++j) { const f32x4 hh = v[j] * rstd * Gc[j] + Sc[j]; v2u w; w.x = pk2(hh.x, hh.y); w.y = pk2(hh.z, hh.w); o[64 * j] = w; }
        }
    }
}
__device__ __forceinline__ void final_norm_phase(Frame& F, const float* x, float* out, const float* g) {
    F.refresh();
    const int gw = F.vcu * NWAVES + F.wave, NGW = F.G * NWAVES;
    for (int row = gw; row < M; row += NGW) {
        const f32x4* xr = (const f32x4*)(x + (size_t)row * D) + F.lane;
        f32x4 v[8]; float ss = 0.f;
#pragma unroll
        for (int j = 0; j < 8; ++j) { v[j] = xr[64 * j]; ss += (v[j].x * v[j].x + v[j].y * v[j].y) + (v[j].z * v[j].z + v[j].w * v[j].w); }
        const float rstd = 1.0f / sqrtf(wave_sum(ss) * (1.0f / D) + EPS);
        f32x4* o = (f32x4*)(out + (size_t)row * D) + F.lane;
#pragma unroll
        for (int j = 0; j < 8; ++j) o[64 * j] = v[j] * rstd * *(const f32x4*)(g + 4 * F.lane + 256 * j);
    }
}

__device__ __forceinline__ void pool_phase(Frame& F, const float* x, bf16* P, const float* g, const float* modp) {
    F.refresh();
    LAS float* tile = (LAS float*)(F.lds);
    LAS float* rst = (LAS float*)(F.lds + 47 * 512 * 4);
    for (int blk = blockIdx.x; blk < M / 32; blk += F.G) {
        const int t0 = 32 * blk, b = t0 / SEQ, tb = t0 & (SEQ - 1), halo = (tb == 0) ? 0 : 15;
        const float* mp = modp + (size_t)b * (3 * D);
        for (int tr = 15 - halo + F.wave; tr < 47; tr += 8) {
            const f32x4* xr = (const f32x4*)(x + (size_t)(t0 - 15 + tr) * D) + F.lane; float ss = 0.f;
#pragma unroll
            for (int j = 0; j < 8; ++j) { const f32x4 v = xr[64 * j]; ss += (v.x * v.x + v.y * v.y) + (v.z * v.z + v.w * v.w); }
            ss = wave_sum(ss);
            if (F.lane == 0) rst[tr] = 1.0f / sqrtf(ss * (1.0f / D) + EPS);
        }
        __syncthreads();
        for (int gi = 0; gi < NPG; ++gi) {
            const int c4 = F.tid & 127, cg = gi * PG + 4 * c4;
            const f32x4 Gc = *(const f32x4*)(g + cg) * (*(const f32x4*)(mp + D + cg) + 1.0f), Sc = *(const f32x4*)(mp + cg);
            for (int tr = 15 - halo + (F.tid >> 7); tr < 47; tr += 4) {
                const f32x4 xv = *(const f32x4*)(x + (size_t)(t0 - 15 + tr) * D + cg);
                *(LAS f32x4*)(tile + tr * 512 + 4 * c4) = xv * rst[tr] * Gc + Sc;
            }
            __syncthreads();
            const int w = 2 << gi, cp = F.tid & 255, i0 = (F.tid >> 8) * 16;
            f32x2 s = {0.f, 0.f};
            {
                const int tpos = tb + i0, nwin = (tpos + 1 < w) ? tpos + 1 : w;
                for (int q = 0; q < nwin; ++q) s += *(const LAS f32x2*)(tile + (i0 + 15 - q) * 512 + 2 * cp);
            }
            for (int k = 0; k < 16; ++k) {
                const int i = i0 + k, tr = i + 15, tpos = tb + i;
                if (k > 0) { s += *(const LAS f32x2*)(tile + tr * 512 + 2 * cp); if (tpos >= w) s -= *(const LAS f32x2*)(tile + (tr - w) * 512 + 2 * cp); }
                const int nwin = (tpos + 1 < w) ? tpos + 1 : w;
                const f32x2 hv = *(const LAS f32x2*)(tile + tr * 512 + 2 * cp);
                const float inv = 1.0f / (float)nwin;
                *(unsigned*)(P + (size_t)(t0 + i) * D + gi * PG + 2 * cp) = pk2(s.x * inv - hv.x, s.y * inv - hv.y);
            }
            __syncthreads();
        }
    }
}

__device__ __forceinline__ void s_phase(Frame& F, const bf16* QD, const bf16* KD, bf16* S, const float* dec) {
    F.refresh();
    const int g = F.lane >> 4, l15 = F.lane & 15;
    for (int pair = blockIdx.x; pair < 256; pair += F.G) {
        for (int half = 0; half < 2; ++half) {
            const int item = 2 * pair + half, itile = half ? 7 - F.wave : F.wave;
            const int bh = item >> 5, c = item & 31, b = bh >> 3, h = bh & 7, r0 = b * SEQ + RC * c;
            const float ssc = dec[2048 + h];
            bf16x8 qf[8];
            const bf16* qrow = QD + (size_t)(r0 + 16 * itile + l15) * D + h * DK + 8 * g;
#pragma unroll
            for (int ks = 0; ks < 8; ++ks) qf[ks] = *(const bf16x8*)(qrow + 32 * ks);
            const int i = 16 * itile + l15;
            bf16* srow = S + ((size_t)item * RC + i) * RC;
            for (int jt = 0; jt < 8; ++jt) {
                f32x4 acc = {0.f, 0.f, 0.f, 0.f};
                if (jt <= itile) {
                    const bf16* krow = KD + (size_t)(r0 + 16 * jt + l15) * D + h * DK + 8 * g;
#pragma unroll
                    for (int ks = 0; ks < 8; ++ks) { const bf16x8 kf = *(const bf16x8*)(krow + 32 * ks); acc = __builtin_amdgcn_mfma_f32_16x16x32_bf16(kf, qf[ks], acc, 0, 0, 0); }
                }
                const int jb = 16 * jt + 4 * g;
                float o[4];
#pragma unroll
                for (int rg = 0; rg < 4; ++rg) o[rg] = (jb + rg <= i) ? acc[rg] * ssc : 0.f;
                v2u w; w.x = pk2(o[0], o[1]); w.y = pk2(o[2], o[3]);
                *(v2u*)(srow + jb) = w;
            }
        }
    }
}

__device__ __forceinline__ bf16x8 tr_frag(unsigned base, int k0, int c0, int rowb, int lane) {
    const int g = lane >> 4, q = (lane & 15) >> 2, p = lane & 3;
    const unsigned a0 = base + (unsigned)((k0 + 8 * g + q) * rowb + (c0 + 4 * p) * 2), a1 = a0 + 4u * (unsigned)rowb;
    bf16x4 lo, hi;
    asm volatile("ds_read_b64_tr_b16 %0, %2\n\tds_read_b64_tr_b16 %1, %3\n\ts_waitcnt lgkmcnt(0)" : "=&v"(lo), "=&v"(hi) : "v"(a0), "v"(a1) : "memory");
    return __builtin_shufflevector(lo, hi, 0, 1, 2, 3, 4, 5, 6, 7);
}
constexpr int CH_KROW = 528, CH_VROW = 80, CH_SROW = 528;
constexpr int CH_KIMG = 0, CH_VIMG = CH_KIMG + RC * CH_KROW, CH_SIMG = CH_VIMG + RC * CH_VROW;
__device__ __forceinline__ void chain_phase(Frame& F, const bf16* QD, const bf16* KD, const bf16* V, const bf16* S, bf16* Y, const float* dec) {
    F.refresh();
    const int g = F.lane >> 4, l15 = F.lane & 15, w = F.wave;
    const unsigned lbase = (unsigned)(size_t)F.lds;
    for (int it = F.vcu; it < 256; it += F.G) {
        const int bh = it >> 4, es = it & 15, b = bh >> 3, h = bh & 7;
        const float cd = dec[2056 + h];
        f32x4 st[2][2];
#pragma unroll
        for (int a = 0; a < 2; ++a)
#pragma unroll
            for (int n = 0; n < 2; ++n) st[a][n] = (f32x4){0.f, 0.f, 0.f, 0.f};
        for (int c = 0; c < NCH; ++c) {
            const int r0 = b * SEQ + RC * c;
            v4u kreg[8];
#pragma unroll
            for (int n = 0; n < 8; ++n) { const int q = F.tid + NTHR * n, j = q >> 5, ch = q & 31; kreg[n] = *(const v4u*)(KD + (size_t)(r0 + j) * D + h * DK + 8 * ch); }
            const v4u vreg = *(const v4u*)(V + (size_t)(r0 + (F.tid >> 2)) * VD + h * DV + es * 32 + 8 * (F.tid & 3));
            __syncthreads();
#pragma unroll
            for (int n = 0; n < 8; ++n) { const int q = F.tid + NTHR * n, j = q >> 5, ch = q & 31; *(LAS v4u*)(F.lds + CH_KIMG + j * CH_KROW + 16 * ch) = kreg[n]; }
            *(LAS v4u*)(F.lds + CH_VIMG + (F.tid >> 2) * CH_VROW + 16 * (F.tid & 3)) = vreg;
#pragma unroll
            for (int a = 0; a < 2; ++a)
#pragma unroll
                for (int n = 0; n < 2; ++n) { v2u pk; pk.x = pk2(st[a][n][0], st[a][n][1]); pk.y = pk2(st[a][n][2], st[a][n][3]);
                    *(LAS v2u*)(F.lds + CH_SIMG + (16 * n + l15) * CH_SROW + (32 * w + 16 * a + 4 * g) * 2) = pk; }
            __syncthreads();
            bf16x8 bv[4][2];
#pragma unroll
            for (int ks = 0; ks < 4; ++ks)
#pragma unroll
                for (int n = 0; n < 2; ++n) bv[ks][n] = tr_frag(lbase + CH_VIMG, 32 * ks, 16 * n, CH_VROW, F.lane);
            f32x4 acc[2] = {{0.f, 0.f, 0.f, 0.f}, {0.f, 0.f, 0.f, 0.f}};
            const bf16* srow = S + (((size_t)bh * NCH + c) * RC + 16 * w + l15) * RC + 8 * g;
#pragma unroll
            for (int ks = 0; ks < 4; ++ks) { const bf16x8 af = *(const bf16x8*)(srow + 32 * ks);
#pragma unroll
                for (int n = 0; n < 2; ++n) acc[n] = __builtin_amdgcn_mfma_f32_16x16x32_bf16(af, bv[ks][n], acc[n], 0, 0, 0); }
            const bf16* qrow = QD + (size_t)(r0 + 16 * w + l15) * D + h * DK + 8 * g;
#pragma unroll
            for (int ks = 0; ks < 8; ++ks) { const bf16x8 af = *(const bf16x8*)(qrow + 32 * ks);
#pragma unroll
                for (int n = 0; n < 2; ++n) { const bf16x8 bs = *(const LAS bf16x8*)(F.lds + CH_SIMG + (16 * n + l15) * CH_SROW + (32 * ks + 8 * g) * 2);
                    acc[n] = __builtin_amdgcn_mfma_f32_16x16x32_bf16(af, bs, acc[n], 0, 0, 0); } }
#pragma unroll
            for (int a = 0; a < 2; ++a)
#pragma unroll
                for (int n = 0; n < 2; ++n) st[a][n] = st[a][n] * cd;
#pragma unroll
            for (int ks = 0; ks < 4; ++ks)
#pragma unroll
                for (int a = 0; a < 2; ++a) { const bf16x8 ak = tr_frag(lbase + CH_KIMG, 32 * ks, 32 * w + 16 * a, CH_KROW, F.lane);
#pragma unroll
                    for (int n = 0; n < 2; ++n) st[a][n] = __builtin_amdgcn_mfma_f32_16x16x32_bf16(ak, bv[ks][n], st[a][n], 0, 0, 0); }
#pragma unroll
            for (int n = 0; n < 2; ++n)
#pragma unroll
                for (int rg = 0; rg < 4; ++rg) Y[(size_t)(r0 + 16 * w + 4 * g + rg) * VD + h * DV + es * 32 + 16 * n + l15] = (bf16)f2bf(acc[n][rg]);
        }
        __syncthreads();
    }
}
__device__ __forceinline__ void gn_phase(Frame& F, const bf16* Y, const bf16* SG, bf16* Z) {
    F.refresh();
    const int gw = F.vcu * NWAVES + F.wave, NGW = F.G * NWAVES;
    for (int p = gw; p < M * RH; p += NGW) {
        const size_t off = (size_t)(p >> 3) * VD + (p & 7) * DV + 8 * F.lane;
        const v4u yw = *(const v4u*)(Y + off), gwv = *(const v4u*)(SG + off);
        float y[8] = {bflo(yw.x), bfhi(yw.x), bflo(yw.y), bfhi(yw.y), bflo(yw.z), bfhi(yw.z), bflo(yw.w), bfhi(yw.w)};
        const float sg[8] = {bflo(gwv.x), bfhi(gwv.x), bflo(gwv.y), bfhi(gwv.y), bflo(gwv.z), bfhi(gwv.z), bflo(gwv.w), bfhi(gwv.w)};
        float s = 0.f;
#pragma unroll
        for (int j = 0; j < 8; ++j) s += y[j];
        const float mu = wave_sum(s) * (1.0f / DV); float q = 0.f;
#pragma unroll
        for (int j = 0; j < 8; ++j) { y[j] -= mu; q += y[j] * y[j]; }
        const float rstd = 1.0f / sqrtf(wave_sum(q) * (1.0f / DV) + EPS);
        v4u o; o.x = pk2(sg[0] * y[0] * rstd, sg[1] * y[1] * rstd); o.y = pk2(sg[2] * y[2] * rstd, sg[3] * y[3] * rstd);
        o.z = pk2(sg[4] * y[4] * rstd, sg[5] * y[5] * rstd); o.w = pk2(sg[6] * y[6] * rstd, sg[7] * y[7] * rstd);
        *(v4u*)(Z + off) = o;
    }
}

struct Args { const float* in[12]; float* out; unsigned char* ws; int ph_lo, ph_hi; };
__global__ void __launch_bounds__(NTHR, 2) fwd(Args args) {
    extern __shared__ __attribute__((aligned(16))) unsigned char lds[];
    Frame F;
    F.lds = (LAS unsigned char*)lds;
    F.tid = threadIdx.x; F.lane = F.tid & 63; F.wave = __builtin_amdgcn_readfirstlane(F.tid >> 6);
    F.G = gridDim.x; { const int bx = blockIdx.x; F.vcu = (F.G % 8 == 0) ? (bx % 8) * (F.G / 8) + bx / 8 : bx; }
    F.ws = args.ws;
    Inputs in; in.x = args.in[0]; in.c = args.in[1]; in.ada_w = args.in[2]; in.ada_b = args.in[3]; in.norm_g = args.in[4]; in.pool_w = args.in[5]; in.pool_scale = args.in[6];
    in.ret_w_in = args.in[7]; in.ret_w_out = args.in[8]; in.mlp_w1 = args.in[9]; in.mlp_w2 = args.in[10]; in.final_g = args.in[11];
    volatile LAS unsigned* MISC = (volatile LAS unsigned*)(F.lds + MISC_OFF);
    for (int u = F.tid; u < (LDS_BYTES - LDSCTL_OFF) / 4; u += NTHR) ((LAS unsigned*)(F.lds + LDSCTL_OFF))[u] = 0u;
    __syncthreads();
    const int lo = args.ph_lo, hi = args.ph_hi;
    XcdBarrier bar; bar.bar = (unsigned*)(F.ws + WS_CTL) + CW_BAR; bar.x = 0; bar.st = nullptr;
    if (hi - lo > 1) bar = xcd_barrier_post((unsigned*)(F.ws + WS_CTL) + CW_BAR, MISC + 8);
    int ph = 0;
#define PH_ON (lo <= ph && ph < hi)
#define PH_END do { if (PH_ON && ph + 1 < hi) xcd_barrier(bar); ++ph; } while (0)

    float* X = args.out;
    float* mod = (float*)(F.ws + WS_MOD);
    bf16* Hb = (bf16*)(F.ws + WS_H); bf16* Ub = (bf16*)(F.ws + WS_U);
    bf16* QDb = (bf16*)(F.ws + WS_QD); bf16* KDb = (bf16*)(F.ws + WS_KD); bf16* Vb = (bf16*)(F.ws + WS_V); bf16* SGb = (bf16*)(F.ws + WS_SG);
    bf16* Yb = (bf16*)(F.ws + WS_Y); bf16* Zb = (bf16*)(F.ws + WS_Z); bf16* Sb = (bf16*)(F.ws + WS_S);
    const float* dec = (const float*)(F.ws + WS_DEC);

    if (PH_ON) prologue_phase(F, in);
    PH_END;

    for (int L = 0; L < DEPTH; ++L) {
        const float* mod_t = mod + (size_t)(L * 2 + 0) * BATCH * (3 * D);
        const float* mod_m = mod + (size_t)(L * 2 + 1) * BATCH * (3 * D);
        const float* xin = (L == 0) ? in.x : X;
        const int lp = L >> 1;
        if ((L & 1) == 0) {
            if (PH_ON) pool_phase(F, xin, Hb, in.norm_g + (size_t)(L * 2 + 0) * D, mod_t);
            PH_END;
            if (PH_ON) {
                pg8::Gemm g{Hb, (const bf16*)(F.ws + WS_WPOOL) + (size_t)lp * NPG * PG * PG, M, D, PG, D, PG, 1, PG};
                pg8::StaticOrder S; S.init(M, D, F.G, (int)blockIdx.x);
                EpiRes E{xin, X, mod_t + 2 * D, 3 * D, in.pool_scale + (size_t)lp * D};
                pg8::gemm_phase<EpiRes, pg8::StaticOrder, true, true>(F.lds, g, S, E);
            }
            PH_END;
        } else {
            if (PH_ON) norm_phase(F, X, Hb, in.norm_g + (size_t)(L * 2 + 0) * D, mod_t);
            PH_END;
            if (PH_ON) {
                pg8::Gemm g{Hb, (const bf16*)(F.ws + WS_WIN) + (size_t)lp * D * NPROJ, M, NPROJ, D, D, D, 0, 0};
                pg8::StaticOrder S; S.init(M, NPROJ, F.G, (int)blockIdx.x);
                EpiProj E{QDb, KDb, Vb, SGb, (const float*)(F.ws + WS_COS), (const float*)(F.ws + WS_SIN), dec};
                pg8::gemm_phase<EpiProj, pg8::StaticOrder, true, true>(F.lds, g, S, E);
            }
            PH_END;
            if (PH_ON) s_phase(F, QDb, KDb, Sb, dec);
            PH_END;
            if (PH_ON) chain_phase(F, QDb, KDb, Vb, Sb, Yb, dec);
            PH_END;
            if (PH_ON) gn_phase(F, Yb, SGb, Zb);
            PH_END;
            if (PH_ON) {
                pg8::Gemm g{Zb, (const bf16*)(F.ws + WS_WOUT) + (size_t)lp * VD * D, M, D, VD, VD, VD, 0, 0};
                pg8::StaticOrder S; S.init(M, D, F.G, (int)blockIdx.x);
                EpiRes E{X, X, mod_t + 2 * D, 3 * D, nullptr};
                pg8::gemm_phase<EpiRes, pg8::StaticOrder, true, true>(F.lds, g, S, E);
            }
            PH_END;
        }
        if (PH_ON) norm_phase(F, X, Hb, in.norm_g + (size_t)(L * 2 + 1) * D, mod_m);
        PH_END;
        if (PH_ON) {
            pg8::Gemm g{Hb, (const bf16*)(F.ws + WS_W1) + (size_t)L * D * FF, M, FF, D, D, D, 0, 0};
            pg8::StaticOrder S; S.init(M, FF, F.G, (int)blockIdx.x);
            EpiSq E{Ub, FF};
            pg8::gemm_phase<EpiSq, pg8::StaticOrder, true, true>(F.lds, g, S, E);
        }
        PH_END;
        if (PH_ON) {
            pg8::Gemm g{Ub, (const bf16*)(F.ws + WS_W2) + (size_t)L * FF * D, M, D, FF, FF, FF, 0, 0};
            pg8::StaticOrder S; S.init(M, D, F.G, (int)blockIdx.x);
            EpiRes E{X, X, mod_m + 2 * D, 3 * D, nullptr};
            pg8::gemm_phase<EpiRes, pg8::StaticOrder, true, true>(F.lds, g, S, E);
        }
        PH_END;
    }
    if (PH_ON) final_norm_phase(F, X, X, in.final_g);
    PH_END;
#undef PH_ON
#undef PH_END
}
constexpr int N_PHASES = 1 + 2 * (5 + 9) + 1;

extern "C" void kernel_launch(void* const* d_in, const int* in_sizes, int n_in, void* d_out, int out_size, void* d_ws, size_t ws_size, hipStream_t stream) {
    static int grid = 0;
    if (grid == 0) {
        if (n_in != 12 || in_sizes[0] != M * D || out_size != M * D || ws_size < WS_END) { fprintf(stderr, "kernel_launch: unexpected shapes (n_in %d, in0 %d, out %d, ws %zu)\n", n_in, n_in > 0 ? in_sizes[0] : -1, out_size, ws_size); grid = -1; return; }
        int dev = 0, cus = 0, per_cu = 0;
        if (hipGetDevice(&dev) != hipSuccess || hipDeviceGetAttribute(&cus, hipDeviceAttributeMultiprocessorCount, dev) != hipSuccess) { grid = -1; return; }
        if (hipFuncSetAttribute((const void*)fwd, hipFuncAttributeMaxDynamicSharedMemorySize, LDS_BYTES) != hipSuccess) { fprintf(stderr, "kernel_launch: hipFuncSetAttribute failed\n"); grid = -1; return; }
        if (hipOccupancyMaxActiveBlocksPerMultiprocessor(&per_cu, (const void*)fwd, NTHR, LDS_BYTES) != hipSuccess || per_cu < 1) fprintf(stderr, "kernel_launch: occupancy query reports %d\n", per_cu);
        (void)hipGetLastError();
        grid = cus;
    }
    if (grid < 0) return;
    if (hipMemsetAsync((char*)d_ws + WS_CTL, 0, CTL_ZERO_BYTES, stream) != hipSuccess) return;
    Args a{};
    for (int i = 0; i < 12; ++i) a.in[i] = (const float*)d_in[i];
    a.out = (float*)d_out; a.ws = (unsigned char*)d_ws;
#if MK_PER_PHASE
    for (int p = 0; p < N_PHASES; ++p) { a.ph_lo = p; a.ph_hi = p + 1; hipLaunchKernelGGL(fwd, dim3(grid), dim3(NTHR), LDS_BYTES, stream, a); }
#else
    a.ph_lo = 0; a.ph_hi = N_PHASES;
    hipLaunchKernelGGL(fwd, dim3(grid), dim3(NTHR), LDS_BYTES, stream, a);
#endif
    const hipError_t le = hipPeekAtLastError();
    if (le != hipSuccess) fprintf(stderr, "kernel_launch: launch failed: %s\n", hipGetErrorName(le));
}
```

```cpp
#include <hip/hip_runtime.h>
#include <cstdio>
#include <cstdint>

#ifndef MK_PER_PHASE
#define MK_PER_PHASE 0
#endif

namespace pg8 {
#define PG8_LAS __attribute__((address_space(3)))
typedef unsigned short bf16_t;
typedef short bf16x8 __attribute__((ext_vector_type(8)));
typedef float f32x4 __attribute__((ext_vector_type(4)));
typedef unsigned u32x4 __attribute__((ext_vector_type(4)));
constexpr int BM = 256, BK = 64, HALF = 128, HTB = HALF * BK * 2  , STAGE_BYTES = 8 * HTB, NXCD = 8, WGM = 8;

__host__ __device__ __forceinline__ int lds_byte(int r, int c) { const int st = (r >> 4) * 2 + (c >> 5), rr = r & 15, cc = c & 31, ob = rr * 64 + cc * 2; return st * 1024 + (ob ^ (((ob >> 9) & 1) << 5)); }
__host__ __device__ __forceinline__ void stage_rc(int b, int& R, int& C) { const int st = b / 1024, sb = b % 1024, swz = sb ^ (((sb >> 9) & 1) << 5); R = (st >> 1) * 16 + swz / 64; C = (st & 1) * 32 + (swz % 64) / 2; }
__host__ __device__ __forceinline__ int perm32(int rho) { const int n = rho >> 4, i = rho & 15; return 8 * (i >> 2) + 4 * n + (i & 3); }

struct Unit { int pm, pn; };
struct Gemm { const bf16_t* A; const bf16_t* Bt; int M, N, K, lda, ldb, grp_shift, grp_koff; };

struct StaticOrder {
    int nM, nN, nwg, G, c;
    __host__ __device__ void init(int M, int N, int G_, int c_) { nM = M / BM; nN = N / BM; nwg = nM * nN; G = G_; c = c_; }
    __host__ __device__ bool next(int i, Unit& u) const {
        const long L = (long)i * G + c; if (L >= nwg) return false;
        int wgid = (int)L; { const int q = nwg / NXCD, r = nwg % NXCD, xcd = wgid % NXCD, off = wgid / NXCD; wgid = (xcd < r ? xcd * (q + 1) : r * (q + 1) + (xcd - r) * q) + off; }
        const int nig = WGM * nN, gid = wgid / nig, fm = gid * WGM, gsz = (nM - fm) < WGM ? (nM - fm) : WGM;
        u.pm = fm + ((wgid % nig) % gsz); u.pn = (wgid % nig) / gsz; return true;
    }
    __device__ __forceinline__ void a_ready(const Unit&) const {}
    __device__ __forceinline__ void done(const Unit&) const {}
};

__device__ __forceinline__ unsigned cvt_pk_bf16(float lo, float hi) { unsigned r; asm volatile("v_cvt_pk_bf16_f32 %0, %1, %2" : "=v"(r) : "v"(lo), "v"(hi)); return r; }

template <class Epi, class Sched, bool ALIGN_EPI = false, bool SP2 = false>
__device__ __forceinline__ void gemm_phase(PG8_LAS unsigned char* lds, const Gemm g, const Sched& S, const Epi& E) {
    int tid_ = threadIdx.x; asm volatile("" : "+v"(tid_));
    const int tid = tid_, wid = __builtin_amdgcn_readfirstlane(tid >> 6), lane = tid & 63, wr = wid >> 2, wc = wid & 3, fr = lane & 15, fq = lane >> 4;
    const int K = g.K, nt = K / BK;
    unsigned voffA[2], voffB[2];
#pragma unroll
    for (int i = 0; i < 2; ++i) { int R, C; stage_rc(tid * 16 + i * 8192, R, C); const int Rb = Epi::PERM ? ((R & ~31) + perm32(R & 31)) : R;
        voffA[i] = (unsigned)(R * g.lda + C) * 2u; voffB[i] = (unsigned)(Rb * g.ldb + C) * 2u; }
    const size_t kstep = (size_t)(BK * 2);
    const size_t hstepA = (size_t)HALF * g.lda * 2, hstepB = (size_t)HALF * g.ldb * 2;
    const size_t tstepA = 2 * hstepA, tstepB = 2 * hstepB;
    const unsigned ldsw = (unsigned)wid * 1024u;
    const int aoff = lds_byte(wr * 64 + fr, fq * 8), boff = lds_byte(wc * 32 + fr, fq * 8);
#define PG8_APTR(u) ((const char*)g.A + (size_t)(u).pm * tstepA + (size_t)(((u).pn >> g.grp_shift) * g.grp_koff) * 2)
#define PG8_BPTR(u) ((const char*)g.Bt + (size_t)(u).pn * tstepB)
#define PG8_SA(b, h) (((b) * 2 + (h)) * HTB)
#define PG8_SB(b, h) ((4 + (b) * 2 + (h)) * HTB)
#define PG8_STAGE(bufoff, gbase, voff) do { _Pragma("unroll") for (int _i = 0; _i < 2; ++_i) \
        __builtin_amdgcn_global_load_lds((const unsigned*)((const char*)(gbase) + (voff)[_i]), (PG8_LAS unsigned*)(lds + (bufoff) + ldsw + _i * 8192), 16, 0, 0); } while (0)
#define PG8_LDA(dst, b, h) do { _Pragma("unroll") for (int m = 0; m < 4; ++m) _Pragma("unroll") for (int k = 0; k < 2; ++k) dst[m][k] = *(const PG8_LAS bf16x8*)(lds + PG8_SA(b, h) + aoff + m * 2048 + k * 1024); } while (0)
#define PG8_LDB(dst, b, h) do { _Pragma("unroll") for (int n = 0; n < 2; ++n) _Pragma("unroll") for (int k = 0; k < 2; ++k) dst[n][k] = *(const PG8_LAS bf16x8*)(lds + PG8_SB(b, h) + boff + n * 2048 + k * 1024); } while (0)
#define PG8_MMA(ai, bj, At, Bt) do { __builtin_amdgcn_s_setprio(1); _Pragma("unroll") for (int m = 0; m < 4; ++m) _Pragma("unroll") for (int n = 0; n < 2; ++n) _Pragma("unroll") for (int k = 0; k < 2; ++k) \
        acc[ai][bj][m][n] = __builtin_amdgcn_mfma_f32_16x16x32_bf16(Bt[n][k], At[m][k], acc[ai][bj][m][n], 0, 0, 0); __builtin_amdgcn_s_setprio(0); } while (0)
#define PG8_WAIT_V(n) asm volatile("s_waitcnt vmcnt(" #n ")" ::: "memory")
#define PG8_WAIT_L(n) asm volatile("s_waitcnt lgkmcnt(" #n ")" ::: "memory")
#define PG8_BAR __builtin_amdgcn_s_barrier()
#define PG8_SCHED __builtin_amdgcn_sched_barrier(0)
    Unit cur, nxt; int ui = 0;
    if (!S.next(0, cur)) return;
    f32x4 acc[2][2][4][2];
#pragma unroll
    for (int a = 0; a < 2; ++a)
#pragma unroll
        for (int b = 0; b < 2; ++b)
#pragma unroll
            for (int m = 0; m < 4; ++m)
#pragma unroll
                for (int n = 0; n < 2; ++n) acc[a][b][m][n] = (f32x4){0.f, 0.f, 0.f, 0.f};
    bf16x8 At[4][2], B0[2][2], B1[2][2];
    const char* cA = PG8_APTR(cur); const char* cB = PG8_BPTR(cur);
    S.a_ready(cur);
    if constexpr (SP2) {
        PG8_STAGE(PG8_SB(0, 0), cB, voffB); PG8_STAGE(PG8_SB(0, 1), cB + hstepB, voffB); PG8_STAGE(PG8_SA(0, 0), cA, voffA); PG8_STAGE(PG8_SA(0, 1), cA + hstepA, voffA);
        if (wr == 1) PG8_BAR;
        PG8_WAIT_V(2); PG8_BAR;
        PG8_STAGE(PG8_SB(1, 0), cB + kstep, voffB); PG8_STAGE(PG8_SA(1, 0), cA + kstep, voffA); PG8_STAGE(PG8_SB(1, 1), cB + hstepB + kstep, voffB);
        PG8_WAIT_V(6); PG8_BAR;
    } else {
        PG8_STAGE(PG8_SB(0, 0), cB, voffB); PG8_STAGE(PG8_SA(0, 0), cA, voffA); PG8_STAGE(PG8_SB(0, 1), cB + hstepB, voffB); PG8_STAGE(PG8_SA(0, 1), cA + hstepA, voffA);
        if (wr == 1) PG8_BAR;
        PG8_WAIT_V(4); PG8_BAR;
        PG8_STAGE(PG8_SB(1, 0), cB + kstep, voffB); PG8_STAGE(PG8_SA(1, 0), cA + kstep, voffA); PG8_STAGE(PG8_SB(1, 1), cB + hstepB + kstep, voffB);
        PG8_WAIT_V(6); PG8_BAR;
    }
    for (;;) {
        const bool has_next = S.next(ui + 1, nxt);
        const char* nA = has_next ? PG8_APTR(nxt) : cA; const char* nB = has_next ? PG8_BPTR(nxt) : cB;
        for (int t = 0; t < nt; t += 2) {
            const bool last = (t == nt - 2);
            const char* a1 = cA + (size_t)(t + 1) * kstep;
            const char* a2 = last ? nA : cA + (size_t)(t + 2) * kstep; const char* b2 = last ? nB : cB + (size_t)(t + 2) * kstep;
            const char* a3 = a2 + kstep; const char* b3 = b2 + kstep;
            if (last && has_next) S.a_ready(nxt);
            if constexpr (SP2) {
            PG8_LDB(B0, 0, 0); PG8_LDB(B1, 0, 1); PG8_SCHED; PG8_LDA(At, 0, 0); PG8_STAGE(PG8_SA(1, 1), a1 + hstepA, voffA);
            PG8_WAIT_V(8); PG8_WAIT_L(0); PG8_BAR; PG8_MMA(0, 0, At, B0); PG8_MMA(0, 1, At, B1); PG8_BAR; PG8_SCHED;
            PG8_LDA(At, 0, 1); PG8_STAGE(PG8_SB(0, 0), b2, voffB); PG8_STAGE(PG8_SB(0, 1), b2 + hstepB, voffB); PG8_STAGE(PG8_SA(0, 0), a2, voffA);
            PG8_WAIT_V(8); PG8_WAIT_L(0); PG8_BAR; PG8_MMA(1, 0, At, B0); PG8_MMA(1, 1, At, B1); PG8_BAR; PG8_SCHED;
            PG8_LDB(B0, 1, 0); PG8_LDB(B1, 1, 1); PG8_SCHED; PG8_LDA(At, 1, 0); PG8_STAGE(PG8_SA(0, 1), a2 + hstepA, voffA);
            PG8_WAIT_V(8); PG8_WAIT_L(0); PG8_BAR; PG8_MMA(0, 0, At, B0); PG8_MMA(0, 1, At, B1); PG8_BAR; PG8_SCHED;
            PG8_LDA(At, 1, 1); PG8_STAGE(PG8_SB(1, 0), b3, voffB); PG8_STAGE(PG8_SB(1, 1), b3 + hstepB, voffB); PG8_STAGE(PG8_SA(1, 0), a3, voffA);
            PG8_WAIT_V(8); PG8_WAIT_L(0); PG8_BAR; PG8_MMA(1, 0, At, B0); PG8_MMA(1, 1, At, B1); PG8_BAR; PG8_SCHED;
            } else {
            PG8_LDB(B0, 0, 0); PG8_SCHED; PG8_LDA(At, 0, 0); PG8_STAGE(PG8_SA(1, 1), a1 + hstepA, voffA);
            PG8_WAIT_L(8); PG8_BAR; PG8_WAIT_L(0); PG8_MMA(0, 0, At, B0); PG8_BAR; PG8_SCHED;
            PG8_LDB(B1, 0, 1); PG8_STAGE(PG8_SB(0, 0), b2, voffB);
            PG8_BAR; PG8_WAIT_L(0); PG8_MMA(0, 1, At, B1); PG8_BAR;
            PG8_LDA(At, 0, 1); PG8_STAGE(PG8_SA(0, 0), a2, voffA);
            PG8_BAR; PG8_WAIT_L(0); PG8_MMA(1, 0, At, B0); PG8_BAR; PG8_SCHED;
            PG8_STAGE(PG8_SB(0, 1), b2 + hstepB, voffB);
            PG8_WAIT_V(6); PG8_BAR; PG8_MMA(1, 1, At, B1); PG8_BAR;
            PG8_LDB(B0, 1, 0); PG8_SCHED; PG8_LDA(At, 1, 0); PG8_STAGE(PG8_SA(0, 1), a2 + hstepA, voffA);
            PG8_WAIT_L(8); PG8_BAR; PG8_WAIT_L(0); PG8_MMA(0, 0, At, B0); PG8_BAR; PG8_SCHED;
            PG8_LDB(B1, 1, 1); PG8_STAGE(PG8_SB(1, 0), b3, voffB);
            PG8_BAR; PG8_WAIT_L(0); PG8_MMA(0, 1, At, B1); PG8_BAR;
            PG8_LDA(At, 1, 1); PG8_STAGE(PG8_SA(1, 0), a3, voffA);
            PG8_BAR; PG8_WAIT_L(0); PG8_MMA(1, 0, At, B0); PG8_BAR; PG8_SCHED;
            PG8_STAGE(PG8_SB(1, 1), b3 + hstepB, voffB);
            PG8_WAIT_V(6); PG8_BAR; PG8_MMA(1, 1, At, B1); PG8_BAR;
            }
        }
        if constexpr (ALIGN_EPI) { if (wr == 0) PG8_BAR; }
        E(acc, cur, wr, wc, fr, fq);
        if (!has_next) break;
#pragma unroll
        for (int a = 0; a < 2; ++a)
#pragma unroll
            for (int b = 0; b < 2; ++b)
#pragma unroll
                for (int m = 0; m < 4; ++m)
#pragma unroll
                    for (int n = 0; n < 2; ++n) acc[a][b][m][n] = (f32x4){0.f, 0.f, 0.f, 0.f};
        cur = nxt; cA = nA; cB = nB; ++ui;
        if constexpr (ALIGN_EPI) { if (wr == 1) PG8_BAR; }
    }
    PG8_WAIT_V(0);
    if constexpr (!ALIGN_EPI) { if (wr == 0) PG8_BAR; }
    PG8_BAR;
#undef PG8_APTR
#undef PG8_BPTR
#undef PG8_SA
#undef PG8_SB
#undef PG8_STAGE
#undef PG8_LDA
#undef PG8_LDB
#undef PG8_MMA
#undef PG8_WAIT_V
#undef PG8_WAIT_L
#undef PG8_BAR
#undef PG8_SCHED
}
}

constexpr int NWAVES = 8, NTHR = NWAVES * 64;
constexpr int BATCH = 2, SEQ = 4096, D = 2048, DEPTH = 4, M = BATCH * SEQ;
constexpr int NPG = 4, PG = 512;
constexpr int RH = 8, DK = 256, DV = 512, VD = 4096, RC = 128, NCH = SEQ / RC;
constexpr int NPROJ = 2 * D + 2 * VD;
constexpr int FF = 4 * D;
constexpr float EPS = 1e-6f;

constexpr size_t MiB = 1u << 20;
constexpr size_t WS_CTL = 0, CTL_ZERO_BYTES = 64 * 1024;
constexpr size_t WS_MOD = 1 * MiB;
constexpr size_t WS_DEC = 2 * MiB;
constexpr size_t WS_COS = 3 * MiB, WS_SIN = 5 * MiB;
constexpr size_t WS_WPOOL = 8 * MiB;
constexpr size_t WS_WIN = 12 * MiB;
constexpr size_t WS_WOUT = 108 * MiB;
constexpr size_t WS_W1 = 140 * MiB;
constexpr size_t WS_W2 = 268 * MiB;
constexpr size_t WS_H = 396 * MiB;
constexpr size_t WS_U = 428 * MiB;
constexpr size_t WS_QD = 556 * MiB;
constexpr size_t WS_KD = 588 * MiB;
constexpr size_t WS_V = 620 * MiB;
constexpr size_t WS_SG = 684 * MiB;
constexpr size_t WS_Y = 748 * MiB;
constexpr size_t WS_Z = 812 * MiB;
constexpr size_t WS_S = 876 * MiB;
constexpr size_t WS_END = 892 * MiB;
constexpr int CW_BAR = 4096;

constexpr int RING_BYTES = 131072;
constexpr int LDSCTL_OFF = RING_BYTES, MISC_OFF = LDSCTL_OFF + 320;
constexpr int LDS_BYTES = 147456;

#define GAS __attribute__((address_space(1)))
#define LAS __attribute__((address_space(3)))
typedef unsigned short bf16;
typedef unsigned v4u __attribute__((ext_vector_type(4)));
typedef unsigned v2u __attribute__((ext_vector_type(2)));
typedef float f32x4 __attribute__((ext_vector_type(4)));
typedef float f32x2 __attribute__((ext_vector_type(2)));
typedef short bf16x8 __attribute__((ext_vector_type(8)));
typedef short bf16x4 __attribute__((ext_vector_type(4)));
typedef GAS unsigned gu32;
#define RLX_AGENT __ATOMIC_RELAXED, __HIP_MEMORY_SCOPE_AGENT
__device__ __forceinline__ unsigned f2bf(float f) { unsigned u = __builtin_bit_cast(unsigned, f); return (u + 0x7fffu + ((u >> 16) & 1u)) >> 16; }
__device__ __forceinline__ unsigned pk2(float lo, float hi) { return f2bf(lo) | (f2bf(hi) << 16); }
__device__ __forceinline__ float bf2f(unsigned short b) { return __builtin_bit_cast(float, ((unsigned)b) << 16); }
__device__ __forceinline__ float bflo(unsigned w) { return __builtin_bit_cast(float, w << 16); }
__device__ __forceinline__ float bfhi(unsigned w) { return __builtin_bit_cast(float, w & 0xffff0000u); }

#define XB_TMO      128
#define XB_XCNT(j)  (256  + 64 * (j))
#define XB_XSUB(j)  (1280 + 64 * (j))
#define XB_XGEN(j)  (2304 + 64 * (j))
#define XB_TOP      3328
#define XB_TOPGEN   3392
#define XCD_BAR_WORDS 3456
#define XB_SPIN_CAP (1u << 18)
__device__ __forceinline__ unsigned xb_ld(unsigned* p)              { return __hip_atomic_load(p, __ATOMIC_RELAXED, __HIP_MEMORY_SCOPE_AGENT); }
__device__ __forceinline__ unsigned xb_add(unsigned* p, unsigned v) { return __hip_atomic_fetch_add(p, v, __ATOMIC_RELAXED, __HIP_MEMORY_SCOPE_AGENT); }
__device__ __forceinline__ unsigned xb_xcc_id() { return (unsigned)__builtin_amdgcn_s_getreg((3 << 11) | 20) & 0xFu; }
#define XB_SPIN(cond, bar) do { unsigned _sp = 0; while (cond) { __builtin_amdgcn_s_sleep(1); \
    if ((++_sp & 255u) == 0u) { if (xb_ld(&(bar)[XB_TMO])) break; if (_sp > XB_SPIN_CAP) { atomicAdd(&(bar)[XB_TMO], 1u); break; } } } } while (0)
struct XcdBarrier { unsigned* bar; unsigned x; volatile LAS unsigned* st; };
__device__ __forceinline__ XcdBarrier xcd_barrier_post(unsigned* bar, volatile LAS unsigned* st) {
    XcdBarrier b; b.bar = bar; b.x = xb_xcc_id(); b.st = st;
    if (threadIdx.x == 0) (void)xb_add(&bar[XB_XCNT(b.x)], 1u);
    return b;
}
__device__ __forceinline__ void xcd_barrier_complete(unsigned* bar, unsigned x, unsigned& nloc, unsigned& nx) {
    const unsigned G = gridDim.x * gridDim.y * gridDim.z;
    unsigned sum, cnt, mine, sp = 0u;
    for (;;) {
        sum = 0u; cnt = 0u; mine = 0u;
#pragma unroll
        for (unsigned j = 0; j < 16; ++j) { const unsigned c = xb_ld(&bar[XB_XCNT(j)]); sum += c; cnt += (c > 0u) ? 1u : 0u; mine = (j == x) ? c : mine; }
        if (sum == G) break;
        __builtin_amdgcn_s_sleep(1);
        if ((++sp & 255u) == 0u) { if (xb_ld(&bar[XB_TMO])) break; if (sp > XB_SPIN_CAP) { atomicAdd(&bar[XB_TMO], 1u); break; } }
    }
    nloc = mine > 0u ? mine : 1u; nx = cnt > 0u ? cnt : 1u;
}
__device__ __forceinline__ void xcd_barrier(const XcdBarrier& b) {
    asm volatile("s_waitcnt vmcnt(0)" ::: "memory");
    __syncthreads();
    if (threadIdx.x == 0) {
        unsigned* bar = b.bar;
        __builtin_amdgcn_s_waitcnt(0);
        unsigned nloc = b.st[0], nx = b.st[1];
        if (nloc == 0u) { xcd_barrier_complete(bar, b.x, nloc, nx); b.st[0] = nloc; b.st[1] = nx; }
        const unsigned old = xb_add(&bar[XB_XSUB(b.x)], 1u);
        const unsigned gen = old / nloc;
        if (old + 1u == (gen + 1u) * nloc) {
            __builtin_amdgcn_fence(__ATOMIC_RELEASE, "agent");
            asm volatile("s_waitcnt vmcnt(0)" ::: "memory");
            const unsigned og = xb_add(&bar[XB_TOP], 1u);
            const unsigned tg = og / nx;
            if (og + 1u == (tg + 1u) * nx) xb_add(&bar[XB_TOPGEN], 1u);
            else XB_SPIN(xb_ld(&bar[XB_TOPGEN]) == tg, bar);
            __builtin_amdgcn_fence(__ATOMIC_ACQUIRE, "agent");
            xb_add(&bar[XB_XGEN(b.x)], 1u);
            asm volatile("s_waitcnt vmcnt(0)" ::: "memory");
        } else {
            XB_SPIN(xb_ld(&bar[XB_XGEN(b.x)]) == gen, bar);
            __builtin_amdgcn_fence(__ATOMIC_ACQUIRE, "agent");
            asm volatile("s_waitcnt vmcnt(0)" ::: "memory");
        }
    }
    __syncthreads();
}

struct Frame {
    LAS unsigned char* lds;
    int tid, lane, wave, vcu, G;
    unsigned char* ws;
    __device__ __forceinline__ void refresh() { int t = threadIdx.x; asm volatile("" : "+v"(t)); tid = t; lane = t & 63; wave = __builtin_amdgcn_readfirstlane(t >> 6); }
};
__device__ __forceinline__ float wave_sum(float v) {
#pragma unroll
    for (int o = 1; o < 64; o <<= 1) v += __shfl_xor(v, o);
    return v;
}

using pg8::Unit; using pg8::BM; using pg8::HALF; using pg8::bf16_t; using pg8::u32x4; using pg8::cvt_pk_bf16;
struct EpiRes {
    static constexpr bool PERM = false;
    const float* xin; float* xout; const float* gate; int gstride; const float* ls;
    __device__ __forceinline__ void operator()(const f32x4 (&acc)[2][2][4][2], const Unit& u, int wr, int wc, int fr, int fq) const {
        const int row0 = u.pm * BM + wr * 64 + fr, col0 = u.pn * BM + wc * 32 + 4 * fq;
        const int b = (u.pm * BM) / SEQ;
        f32x4 gv[2][2];
#pragma unroll
        for (int bj = 0; bj < 2; ++bj)
#pragma unroll
            for (int n = 0; n < 2; ++n) { const int c = col0 + bj * HALF + n * 16; f32x4 gg = *(const f32x4*)(gate + (size_t)b * gstride + c); if (ls) gg = gg * *(const f32x4*)(ls + c); gv[bj][n] = gg; }
#pragma unroll
        for (int ai = 0; ai < 2; ++ai)
#pragma unroll
            for (int m = 0; m < 4; ++m) { const size_t off = (size_t)(row0 + ai * HALF + m * 16) * D + col0;
#pragma unroll
                for (int bj = 0; bj < 2; ++bj)
#pragma unroll
                    for (int n = 0; n < 2; ++n) { const f32x4 xi = *(const f32x4*)(xin + off + bj * HALF + n * 16); *(f32x4*)(xout + off + bj * HALF + n * 16) = xi + gv[bj][n] * acc[ai][bj][m][n]; }
                if (m & 1) asm volatile("" ::: "memory"); }
    }
};
struct EpiSq {
    static constexpr bool PERM = true;
    bf16_t* O; int ldc;
    __device__ __forceinline__ void operator()(const f32x4 (&acc)[2][2][4][2], const Unit& u, int wr, int wc, int fr, int fq) const {
        const int row0 = u.pm * BM + wr * 64 + fr, col0 = u.pn * BM + wc * 32 + 8 * fq;
#pragma unroll
        for (int ai = 0; ai < 2; ++ai)
#pragma unroll
            for (int m = 0; m < 4; ++m) { bf16_t* rowp = O + (size_t)(row0 + ai * HALF + m * 16) * ldc + col0;
#pragma unroll
                for (int bj = 0; bj < 2; ++bj) { f32x4 v0 = acc[ai][bj][m][0], v1 = acc[ai][bj][m][1];
#pragma unroll
                    for (int j = 0; j < 4; ++j) { const float a0 = fmaxf(v0[j], 0.f), a1 = fmaxf(v1[j], 0.f); v0[j] = a0 * a0; v1[j] = a1 * a1; }
                    u32x4 w; w.x = cvt_pk_bf16(v0[0], v0[1]); w.y = cvt_pk_bf16(v0[2], v0[3]); w.z = cvt_pk_bf16(v1[0], v1[1]); w.w = cvt_pk_bf16(v1[2], v1[3]);
                    *(u32x4*)(rowp + bj * HALF) = w; } }
    }
};
struct EpiProj {
    static constexpr bool PERM = true;
    bf16_t *QD, *KD, *V, *SG; const float *cosT, *sinT, *dec;
    __device__ __forceinline__ void operator()(const f32x4 (&acc)[2][2][4][2], const Unit& u, int wr, int wc, int fr, int fq) const {
        const int row0 = u.pm * BM + wr * 64 + fr, c0 = wc * 32 + 8 * fq;
        if (u.pn < 16) {
            const int h = u.pn & 7; const bool isk = u.pn >= 8;
            bf16_t* base = (isk ? KD : QD) + h * DK + c0;
            const float* dtab = dec + (isk ? 1024 : 0) + h * RC;
#pragma unroll
            for (int ai = 0; ai < 2; ++ai)
#pragma unroll
                for (int m = 0; m < 4; ++m) { const int r = row0 + ai * HALF + m * 16; const int pos = r & (SEQ - 1); const float dc = dtab[r & (RC - 1)];
#pragma unroll
                    for (int bj = 0; bj < 2; ++bj) { const int pi = (c0 + bj * HALF) >> 1;
                        const f32x4 cs = *(const f32x4*)(cosT + (size_t)pos * 128 + pi), sn = *(const f32x4*)(sinT + (size_t)pos * 128 + pi);
                        const f32x4 v0 = acc[ai][bj][m][0], v1 = acc[ai][bj][m][1];
                        const float o0 = (v0[0] * cs[0] - v0[1] * sn[0]) * dc, o1 = (v0[0] * sn[0] + v0[1] * cs[0]) * dc;
                        const float o2 = (v0[2] * cs[1] - v0[3] * sn[1]) * dc, o3 = (v0[2] * sn[1] + v0[3] * cs[1]) * dc;
                        const float o4 = (v1[0] * cs[2] - v1[1] * sn[2]) * dc, o5 = (v1[0] * sn[2] + v1[1] * cs[2]) * dc;
                        const float o6 = (v1[2] * cs[3] - v1[3] * sn[3]) * dc, o7 = (v1[2] * sn[3] + v1[3] * cs[3]) * dc;
                        u32x4 w; w.x = cvt_pk_bf16(o0, o1); w.y = cvt_pk_bf16(o2, o3); w.z = cvt_pk_bf16(o4, o5); w.w = cvt_pk_bf16(o6, o7);
                        *(u32x4*)(base + (size_t)r * D + bj * HALF) = w; }
                    if (m & 1) asm volatile("" ::: "memory"); }
        } else {
            const bool isg = u.pn >= 32;
            bf16_t* base = (isg ? SG : V) + (u.pn - (isg ? 32 : 16)) * BM + c0;
#pragma unroll
            for (int ai = 0; ai < 2; ++ai)
#pragma unroll
                for (int m = 0; m < 4; ++m) { const int r = row0 + ai * HALF + m * 16;
#pragma unroll
                    for (int bj = 0; bj < 2; ++bj) { f32x4 v0 = acc[ai][bj][m][0], v1 = acc[ai][bj][m][1];
                        if (isg) {
#pragma unroll
                            for (int j = 0; j < 4; ++j) { v0[j] = v0[j] * __builtin_amdgcn_rcpf(1.0f + __expf(-v0[j])); v1[j] = v1[j] * __builtin_amdgcn_rcpf(1.0f + __expf(-v1[j])); } }
                        u32x4 w; w.x = cvt_pk_bf16(v0[0], v0[1]); w.y = cvt_pk_bf16(v0[2], v0[3]); w.z = cvt_pk_bf16(v1[0], v1[1]); w.w = cvt_pk_bf16(v1[2], v1[3]);
                        *(u32x4*)(base + (size_t)r * VD + bj * HALF) = w; } }
        }
    }
};

__device__ __forceinline__ void p0_transpose_item(const float* W, int K, int N, bf16* WT, LAS float* scr, int item, int lane) {
    const int nblk = N / 32, kb = item / nblk, nb = item % nblk, k0 = 64 * kb, n0 = 32 * nb;
#pragma unroll 8
    for (int i = 0; i < 32; ++i) { const int kk = 2 * i + (lane >> 5); scr[kk * 33 + (lane & 31)] = W[(size_t)(k0 + kk) * N + n0 + (lane & 31)]; }
    asm volatile("s_waitcnt lgkmcnt(0)" ::: "memory");
    const int c = lane & 7;
#pragma unroll
    for (int j = 0; j < 4; ++j) { const int n = (lane >> 3) + 8 * j; const LAS float* s = scr + (8 * c) * 33 + n;
        v4u o; o.x = pk2(s[0 * 33], s[1 * 33]); o.y = pk2(s[2 * 33], s[3 * 33]); o.z = pk2(s[4 * 33], s[5 * 33]); o.w = pk2(s[6 * 33], s[7 * 33]);
        *(v4u*)(WT + (size_t)(n0 + n) * K + k0 + 8 * c) = o; }
    asm volatile("s_waitcnt lgkmcnt(0)" ::: "memory");
}
struct Inputs { const float *x, *c, *ada_w, *ada_b, *norm_g, *pool_w, *pool_scale, *ret_w_in, *ret_w_out, *mlp_w1, *mlp_w2, *final_g; };

__device__ __forceinline__ void prologue_phase(Frame& F, const Inputs& in) {
    F.refresh();
    LAS float* cond = (LAS float*)(F.lds);
    LAS float* red = (LAS float*)(F.lds + 16384);
    for (int i = F.tid; i < BATCH * D; i += NTHR) { const float cv = in.c[i]; cond[i] = cv / (1.0f + expf(-cv)); }
    __syncthreads();
    float* mod = (float*)(F.ws + WS_MOD);
    for (int it = blockIdx.x; it < 8 * 96; it += F.G) {
        const int is = it / 96, col0 = (it % 96) * 64;
        const float* W = in.ada_w + (size_t)is * D * (3 * D) + col0;
        const int rsub = F.lane >> 4, cq = F.lane & 15, d0 = F.wave * 256;
        f32x4 a0 = {0.f, 0.f, 0.f, 0.f}, a1 = {0.f, 0.f, 0.f, 0.f};
#pragma unroll 8
        for (int rr = 0; rr < 256; rr += 4) { const int d = d0 + rr + rsub; const f32x4 wv = *(const f32x4*)(W + (size_t)d * (3 * D) + 4 * cq);
            const float c0 = cond[d], c1 = cond[D + d]; a0 += wv * c0; a1 += wv * c1; }
#pragma unroll
        for (int j = 0; j < 4; ++j) { a0[j] += __shfl_xor(a0[j], 16); a0[j] += __shfl_xor(a0[j], 32); a1[j] += __shfl_xor(a1[j], 16); a1[j] += __shfl_xor(a1[j], 32); }
        if (rsub == 0) { *(LAS f32x4*)(red + (F.wave * 2 + 0) * 64 + 4 * cq) = a0; *(LAS f32x4*)(red + (F.wave * 2 + 1) * 64 + 4 * cq) = a1; }
        __syncthreads();
        if (F.tid < 128) { const int b = F.tid >> 6, cc = F.tid & 63; float s = 0.f;
#pragma unroll
            for (int w = 0; w < 8; ++w) s += red[(w * 2 + b) * 64 + cc];
            mod[((size_t)is * BATCH + b) * (3 * D) + col0 + cc] = s + in.ada_b[(size_t)is * (3 * D) + col0 + cc]; }
        __syncthreads();
    }
    {
        LAS float* scr = (LAS float*)(F.lds + 32768 + F.wave * 8704);
        const int gw = F.vcu * NWAVES + F.wave, NGW = F.G * NWAVES;
        constexpr int I_P = (PG / 64) * (PG / 32), I_IN = (D / 64) * (NPROJ / 32), I_OUT = (VD / 64) * (D / 32), I_1 = (D / 64) * (FF / 32), I_2 = (FF / 64) * (D / 32);
        constexpr int N_P = 8 * I_P, N_IN = 2 * I_IN, N_OUT = 2 * I_OUT, N_1 = 4 * I_1, N_2 = 4 * I_2;
        for (int it = gw; it < N_P + N_IN + N_OUT + N_1 + N_2; it += NGW) {
            int r = it;
            if (r < N_P) { const int mt = r / I_P; p0_transpose_item(in.pool_w + (size_t)mt * PG * PG, PG, PG, (bf16*)(F.ws + WS_WPOOL) + (size_t)mt * PG * PG, scr, r % I_P, F.lane); continue; } r -= N_P;
            if (r < N_IN) { const int mt = r / I_IN; p0_transpose_item(in.ret_w_in + (size_t)mt * D * NPROJ, D, NPROJ, (bf16*)(F.ws + WS_WIN) + (size_t)mt * D * NPROJ, scr, r % I_IN, F.lane); continue; } r -= N_IN;
            if (r < N_OUT) { const int mt = r / I_OUT; p0_transpose_item(in.ret_w_out + (size_t)mt * VD * D, VD, D, (bf16*)(F.ws + WS_WOUT) + (size_t)mt * VD * D, scr, r % I_OUT, F.lane); continue; } r -= N_OUT;
            if (r < N_1) { const int mt = r / I_1; p0_transpose_item(in.mlp_w1 + (size_t)mt * D * FF, D, FF, (bf16*)(F.ws + WS_W1) + (size_t)mt * D * FF, scr, r % I_1, F.lane); continue; } r -= N_1;
            { const int mt = r / I_2; p0_transpose_item(in.mlp_w2 + (size_t)mt * FF * D, FF, D, (bf16*)(F.ws + WS_W2) + (size_t)mt * FF * D, scr, r % I_2, F.lane); }
        }
    }
    {
        float* cosT = (float*)(F.ws + WS_COS); float* sinT = (float*)(F.ws + WS_SIN);
        const int gt = blockIdx.x * NTHR + F.tid, NGT = F.G * NTHR;
        for (int e = gt; e < SEQ * 128; e += NGT) {
            const int pos = e >> 7, i = e & 127;
            double inv = 1.0, bp = 0.9305720409296989792906463164991290590767;
#pragma unroll
            for (int bit = 0; bit < 7; ++bit) { if ((i >> bit) & 1) inv *= bp; bp *= bp; }
            const double ang = (double)pos * inv;
            const double kq = __builtin_rint(ang * 0.6366197723675814);
            double r = __builtin_fma(-kq, 1.5707963267948966, ang); r = __builtin_fma(-kq, 6.123233995736766e-17, r);
            const double r2 = r * r;
            double sp = -1.0 / 1307674368000.0;
            sp = sp * r2 + 1.0 / 6227020800.0; sp = sp * r2 - 1.0 / 39916800.0; sp = sp * r2 + 1.0 / 362880.0; sp = sp * r2 - 1.0 / 5040.0; sp = sp * r2 + 1.0 / 120.0; sp = sp * r2 - 1.0 / 6.0; sp = sp * r2 + 1.0;
            const double sr = sp * r;
            double cp = 1.0 / 20922789888000.0;
            cp = cp * r2 - 1.0 / 87178291200.0; cp = cp * r2 + 1.0 / 479001600.0; cp = cp * r2 - 1.0 / 3628800.0; cp = cp * r2 + 1.0 / 40320.0; cp = cp * r2 - 1.0 / 720.0; cp = cp * r2 + 1.0 / 24.0; cp = cp * r2 - 0.5; cp = cp * r2 + 1.0;
            const int q = ((int)kq) & 3;
            const double sv = (q == 0) ? sr : (q == 1) ? cp : (q == 2) ? -sr : -cp;
            const double cv = (q == 0) ? cp : (q == 1) ? -sr : (q == 2) ? -cp : sr;
            cosT[e] = (float)cv; sinT[e] = (float)sv;
        }
        if (blockIdx.x == 0 && F.tid < RH) {
            float* dec = (float*)(F.ws + WS_DEC); const int h = F.tid;
            const double gam = 1.0 - __builtin_ldexp(1.0, -5 - h);
            double p = 1.0;
            for (int i = 0; i < RC; ++i) { p *= gam; dec[h * RC + i] = (float)p; }
            const double g128 = p;
            double q = 1.0 / 16.0;
            for (int j = RC - 1; j >= 0; --j) { dec[1024 + h * RC + j] = (float)q; q *= gam; }
            dec[2048 + h] = (float)(1.0 / g128);
            dec[2056 + h] = (float)g128;
        }
    }
}

__device__ __forceinline__ void norm_phase(Frame& F, const float* x, bf16* H, const float* g, const float* modp) {
    F.refresh();
    const int gw = F.vcu * NWAVES + F.wave, NGW = F.G * NWAVES;
    for (int r4 = gw; r4 < M / 4; r4 += NGW) {
        const int b = (4 * r4) / SEQ; const float* mp = modp + (size_t)b * (3 * D);
        f32x4 Gc[8], Sc[8];
#pragma unroll
        for (int j = 0; j < 8; ++j) { const int c = 4 * F.lane + 256 * j; const f32x4 gg = *(const f32x4*)(g + c), sc = *(const f32x4*)(mp + D + c); Gc[j] = gg * (sc + 1.0f); Sc[j] = *(const f32x4*)(mp + c); }
        for (int rr = 0; rr < 4; ++rr) {
            const size_t row = (size_t)4 * r4 + rr; const f32x4* xr = (const f32x4*)(x + row * D) + F.lane;
            f32x4 v[8]; float ss = 0.f;
#pragma unroll
            for (int j = 0; j < 8; ++j) { v[j] = xr[64 * j]; ss += (v[j].x * v[j].x + v[j].y * v[j].y) + (v[j].z * v[j].z + v[j].w * v[j].w); }
            const float rstd = 1.0f / sqrtf(wave_sum(ss) * (1.0f / D) + EPS);
            v2u* o = (v2u*)(H + row * D) + F.lane;
#pragma unroll
            for (int j = 0; j < 8; ++j) { const f32x4 hh = v[j] * rstd * Gc[j] + Sc[j]; v2u w; w.x = pk2(hh.x, hh.y); w.y = pk2(hh.z, hh.w); o[64 * j] = w; }
        }
    }
}
__device__ __forceinline__ void final_norm_phase(Frame& F, const float* x, float* out, const float* g) {
    F.refresh();
    const int gw = F.vcu * NWAVES + F.wave, NGW = F.G * NWAVES;
    for (int row = gw; row < M; row += NGW) {
        const f32x4* xr = (const f32x4*)(x + (size_t)row * D) + F.lane;
        f32x4 v[8]; float ss = 0.f;
#pragma unroll
        for (int j = 0; j < 8; ++j) { v[j] = xr[64 * j]; ss += (v[j].x * v[j].x + v[j].y * v[j].y) + (v[j].z * v[j].z + v[j].w * v[j].w); }
        const float rstd = 1.0f / sqrtf(wave_sum(ss) * (1.0f / D) + EPS);
        f32x4* o = (f32x4*)(out + (size_t)row * D) + F.lane;
#pragma unroll
        for (int j = 0; j < 8; ++j) o[64 * j] = v[j] * rstd * *(const f32x4*)(g + 4 * F.lane + 256 * j);
    }
}

__device__ __forceinline__ void pool_phase(Frame& F, const float* x, bf16* P, const float* g, const float* modp) {
    F.refresh();
    LAS float* tile = (LAS float*)(F.lds);
    LAS float* rst = (LAS float*)(F.lds + 47 * 512 * 4);
    for (int blk = blockIdx.x; blk < M / 32; blk += F.G) {
        const int t0 = 32 * blk, b = t0 / SEQ, tb = t0 & (SEQ - 1), halo = (tb == 0) ? 0 : 15;
        const float* mp = modp + (size_t)b * (3 * D);
        for (int tr = 15 - halo + F.wave; tr < 47; tr += 8) {
            const f32x4* xr = (const f32x4*)(x + (size_t)(t0 - 15 + tr) * D) + F.lane; float ss = 0.f;
#pragma unroll
            for (int j = 0; j < 8; ++j) { const f32x4 v = xr[64 * j]; ss += (v.x * v.x + v.y * v.y) + (v.z * v.z + v.w * v.w); }
            ss = wave_sum(ss);
            if (F.lane == 0) rst[tr] = 1.0f / sqrtf(ss * (1.0f / D) + EPS);
        }
        __syncthreads();
        for (int gi = 0; gi < NPG; ++gi) {
            const int c4 = F.tid & 127, cg = gi * PG + 4 * c4;
            const f32x4 Gc = *(const f32x4*)(g + cg) * (*(const f32x4*)(mp + D + cg) + 1.0f), Sc = *(const f32x4*)(mp + cg);
            for (int tr = 15 - halo + (F.tid >> 7); tr < 47; tr += 4) {
                const f32x4 xv = *(const f32x4*)(x + (size_t)(t0 - 15 + tr) * D + cg);
                *(LAS f32x4*)(tile + tr * 512 + 4 * c4) = xv * rst[tr] * Gc + Sc;
            }
            __syncthreads();
            const int w = 2 << gi, cp = F.tid & 255, i0 = (F.tid >> 8) * 16;
            f32x2 s = {0.f, 0.f};
            {
                const int tpos = tb + i0, nwin = (tpos + 1 < w) ? tpos + 1 : w;
                for (int q = 0; q < nwin; ++q) s += *(const LAS f32x2*)(tile + (i0 + 15 - q) * 512 + 2 * cp);
            }
            for (int k = 0; k < 16; ++k) {
                const int i = i0 + k, tr = i + 15, tpos = tb + i;
                if (k > 0) { s += *(const LAS f32x2*)(tile + tr * 512 + 2 * cp); if (tpos >= w) s -= *(const LAS f32x2*)(tile + (tr - w) * 512 + 2 * cp); }
                const int nwin = (tpos + 1 < w) ? tpos + 1 : w;
                const f32x2 hv = *(const LAS f32x2*)(tile + tr * 512 + 2 * cp);
                const float inv = 1.0f / (float)nwin;
                *(unsigned*)(P + (size_t)(t0 + i) * D + gi * PG + 2 * cp) = pk2(s.x * inv - hv.x, s.y * inv - hv.y);
            }
            __syncthreads();
        }
    }
}

__device__ __forceinline__ void s_phase(Frame& F, const bf16* QD, const bf16* KD, bf16* S, const float* dec) {
    F.refresh();
    const int g = F.lane >> 4, l15 = F.lane & 15;
    for (int pair = blockIdx.x; pair < 256; pair += F.G) {
        for (int half = 0; half < 2; ++half) {
            const int item = 2 * pair + half, itile = half ? 7 - F.wave : F.wave;
            const int bh = item >> 5, c = item & 31, b = bh >> 3, h = bh & 7, r0 = b * SEQ + RC * c;
            const float ssc = dec[2048 + h];
            bf16x8 qf[8];
            const bf16* qrow = QD + (size_t)(r0 + 16 * itile + l15) * D + h * DK + 8 * g;
#pragma unroll
            for (int ks = 0; ks < 8; ++ks) qf[ks] = *(const bf16x8*)(qrow + 32 * ks);
            const int i = 16 * itile + l15;
            bf16* srow = S + ((size_t)item * RC + i) * RC;
            for (int jt = 0; jt < 8; ++jt) {
                f32x4 acc = {0.f, 0.f, 0.f, 0.f};
                if (jt <= itile) {
                    const bf16* krow = KD + (size_t)(r0 + 16 * jt + l15) * D + h * DK + 8 * g;
#pragma unroll
                    for (int ks = 0; ks < 8; ++ks) { const bf16x8 kf = *(const bf16x8*)(krow + 32 * ks); acc = __builtin_amdgcn_mfma_f32_16x16x32_bf16(kf, qf[ks], acc, 0, 0, 0); }
                }
                const int jb = 16 * jt + 4 * g;
                float o[4];
#pragma unroll
                for (int rg = 0; rg < 4; ++rg) o[rg] = (jb + rg <= i) ? acc[rg] * ssc : 0.f;
                v2u w; w.x = pk2(o[0], o[1]); w.y = pk2(o[2], o[3]);
                *(v2u*)(srow + jb) = w;
            }
        }
    }
}

__device__ __forceinline__ bf16x8 tr_frag(unsigned base, int k0, int c0, int rowb, int lane) {
    const int g = lane >> 4, q = (lane & 15) >> 2, p = lane & 3;
    const unsigned a0 = base + (unsigned)((k0 + 8 * g + q) * rowb + (c0 + 4 * p) * 2), a1 = a0 + 4u * (unsigned)rowb;
    bf16x4 lo, hi;
    asm volatile("ds_read_b64_tr_b16 %0, %2\n\tds_read_b64_tr_b16 %1, %3\n\ts_waitcnt lgkmcnt(0)" : "=&v"(lo), "=&v"(hi) : "v"(a0), "v"(a1) : "memory");
    return __builtin_shufflevector(lo, hi, 0, 1, 2, 3, 4, 5, 6, 7);
}
constexpr int CH_KROW = 528, CH_VROW = 80, CH_SROW = 528;
constexpr int CH_KIMG = 0, CH_VIMG = CH_KIMG + RC * CH_KROW, CH_SIMG = CH_VIMG + RC * CH_VROW;
__device__ __forceinline__ void chain_phase(Frame& F, const bf16* QD, const bf16* KD, const bf16* V, const bf16* S, bf16* Y, const float* dec) {
    F.refresh();
    const int g = F.lane >> 4, l15 = F.lane & 15, w = F.wave;
    const unsigned lbase = (unsigned)(size_t)F.lds;
    for (int it = F.vcu; it < 256; it += F.G) {
        const int bh = it >> 4, es = it & 15, b = bh >> 3, h = bh & 7;
        const float cd = dec[2056 + h];
        f32x4 st[2][2];
#pragma unroll
        for (int a = 0; a < 2; ++a)
#pragma unroll
            for (int n = 0; n < 2; ++n) st[a][n] = (f32x4){0.f, 0.f, 0.f, 0.f};
        for (int c = 0; c < NCH; ++c) {
            const int r0 = b * SEQ + RC * c;
            v4u kreg[8];
#pragma unroll
            for (int n = 0; n < 8; ++n) { const int q = F.tid + NTHR * n, j = q >> 5, ch = q & 31; kreg[n] = *(const v4u*)(KD + (size_t)(r0 + j) * D + h * DK + 8 * ch); }
            const v4u vreg = *(const v4u*)(V + (size_t)(r0 + (F.tid >> 2)) * VD + h * DV + es * 32 + 8 * (F.tid & 3));
            __syncthreads();
#pragma unroll
            for (int n = 0; n < 8; ++n) { const int q = F.tid + NTHR * n, j = q >> 5, ch = q & 31; *(LAS v4u*)(F.lds + CH_KIMG + j * CH_KROW + 16 * ch) = kreg[n]; }
            *(LAS v4u*)(F.lds + CH_VIMG + (F.tid >> 2) * CH_VROW + 16 * (F.tid & 3)) = vreg;
#pragma unroll
            for (int a = 0; a < 2; ++a)
#pragma unroll
                for (int n = 0; n < 2; ++n) { v2u pk; pk.x = pk2(st[a][n][0], st[a][n][1]); pk.y = pk2(st[a][n][2], st[a][n][3]);
                    *(LAS v2u*)(F.lds + CH_SIMG + (16 * n + l15) * CH_SROW + (32 * w + 16 * a + 4 * g) * 2) = pk; }
            __syncthreads();
            bf16x8 bv[4][2];
#pragma unroll
            for (int ks = 0; ks < 4; ++ks)
#pragma unroll
                for (int n = 0; n < 2; ++n) bv[ks][n] = tr_frag(lbase + CH_VIMG, 32 * ks, 16 * n, CH_VROW, F.lane);
            f32x4 acc[2] = {{0.f, 0.f, 0.f, 0.f}, {0.f, 0.f, 0.f, 0.f}};
            const bf16* srow = S + (((size_t)bh * NCH + c) * RC + 16 * w + l15) * RC + 8 * g;
#pragma unroll
            for (int ks = 0; ks < 4; ++ks) { const bf16x8 af = *(const bf16x8*)(srow + 32 * ks);
#pragma unroll
                for (int n = 0; n < 2; ++n) acc[n] = __builtin_amdgcn_mfma_f32_16x16x32_bf16(af, bv[ks][n], acc[n], 0, 0, 0); }
            const bf16* qrow = QD + (size_t)(r0 + 16 * w + l15) * D + h * DK + 8 * g;
#pragma unroll
            for (int ks = 0; ks < 8; ++ks) { const bf16x8 af = *(const bf16x8*)(qrow + 32 * ks);
#pragma unroll
                for (int n = 0; n < 2; ++n) { const bf16x8 bs = *(const LAS bf16x8*)(F.lds + CH_SIMG + (16 * n + l15) * CH_SROW + (32 * ks + 8 * g) * 2);
                    acc[n] = __builtin_amdgcn_mfma_f32_16x16x32_bf16(af, bs, acc[n], 0, 0, 0); } }
#pragma unroll
            for (int a = 0; a < 2; ++a)
#pragma unroll
                for (int n = 0; n < 2; ++n) st[a][n] = st[a][n] * cd;
#pragma unroll
            for (int ks = 0; ks < 4; ++ks)
#pragma unroll
                for (int a = 0; a < 2; ++a) { const bf16x8 ak = tr_frag(lbase + CH_KIMG, 32 * ks, 32 * w + 16 * a, CH_KROW, F.lane);
#pragma unroll
                    for (int n = 0; n < 2; ++n) st[a][n] = __builtin_amdgcn_mfma_f32_16x16x32_bf16(ak, bv[ks][n], st[a][n], 0, 0, 0); }
#pragma unroll
            for (int n = 0; n < 2; ++n)
#pragma unroll
                for (int rg = 0; rg < 4; ++rg) Y[(size_t)(r0 + 16 * w + 4 * g + rg) * VD + h * DV + es * 32 + 16 * n + l15] = (bf16)f2bf(acc[n][rg]);
        }
        __syncthreads();
    }
}
__device__ __forceinline__ void gn_phase(Frame& F, const bf16* Y, const bf16* SG, bf16* Z) {
    F.refresh();
    const int gw = F.vcu * NWAVES + F.wave, NGW = F.G * NWAVES;
    for (int p = gw; p < M * RH; p += NGW) {
        const size_t off = (size_t)(p >> 3) * VD + (p & 7) * DV + 8 * F.lane;
        const v4u yw = *(const v4u*)(Y + off), gwv = *(const v4u*)(SG + off);
        float y[8] = {bflo(yw.x), bfhi(yw.x), bflo(yw.y), bfhi(yw.y), bflo(yw.z), bfhi(yw.z), bflo(yw.w), bfhi(yw.w)};
        const float sg[8] = {bflo(gwv.x), bfhi(gwv.x), bflo(gwv.y), bfhi(gwv.y), bflo(gwv.z), bfhi(gwv.z), bflo(gwv.w), bfhi(gwv.w)};
        float s = 0.f;
#pragma unroll
        for (int j = 0; j < 8; ++j) s += y[j];
        const float mu = wave_sum(s) * (1.0f / DV); float q = 0.f;
#pragma unroll
        for (int j = 0; j < 8; ++j) { y[j] -= mu; q += y[j] * y[j]; }
        const float rstd = 1.0f / sqrtf(wave_sum(q) * (1.0f / DV) + EPS);
        v4u o; o.x = pk2(sg[0] * y[0] * rstd, sg[1] * y[1] * rstd); o.y = pk2(sg[2] * y[2] * rstd, sg[3] * y[3] * rstd);
        o.z = pk2(sg[4] * y[4] * rstd, sg[5] * y[5] * rstd); o.w = pk2(sg[6] * y[6] * rstd, sg[7] * y[7] * rstd);
        *(v4u*)(Z + off) = o;
    }
}

struct Args { const float* in[12]; float* out; unsigned char* ws; int ph_lo, ph_hi; };
__global__ void __launch_bounds__(NTHR, 2) fwd(Args args) {
    extern __shared__ __attribute__((aligned(16))) unsigned char lds[];
    Frame F;
    F.lds = (LAS unsigned char*)lds;
    F.tid = threadIdx.x; F.lane = F.tid & 63; F.wave = __builtin_amdgcn_readfirstlane(F.tid >> 6);
    F.G = gridDim.x; { const int bx = blockIdx.x; F.vcu = (F.G % 8 == 0) ? (bx % 8) * (F.G / 8) + bx / 8 : bx; }
    F.ws = args.ws;
    Inputs in; in.x = args.in[0]; in.c = args.in[1]; in.ada_w = args.in[2]; in.ada_b = args.in[3]; in.norm_g = args.in[4]; in.pool_w = args.in[5]; in.pool_scale = args.in[6];
    in.ret_w_in = args.in[7]; in.ret_w_out = args.in[8]; in.mlp_w1 = args.in[9]; in.mlp_w2 = args.in[10]; in.final_g = args.in[11];
    volatile LAS unsigned* MISC = (volatile LAS unsigned*)(F.lds + MISC_OFF);
    for (int u = F.tid; u < (LDS_BYTES - LDSCTL_OFF) / 4; u += NTHR) ((LAS unsigned*)(F.lds + LDSCTL_OFF))[u] = 0u;
    __syncthreads();
    const int lo = args.ph_lo, hi = args.ph_hi;
    XcdBarrier bar; bar.bar = (unsigned*)(F.ws + WS_CTL) + CW_BAR; bar.x = 0; bar.st = nullptr;
    if (hi - lo > 1) bar = xcd_barrier_post((unsigned*)(F.ws + WS_CTL) + CW_BAR, MISC + 8);
    int ph = 0;
#define PH_ON (lo <= ph && ph < hi)
#define PH_END do { if (PH_ON && ph + 1 < hi) xcd_barrier(bar); ++ph; } while (0)

    float* X = args.out;
    float* mod = (float*)(F.ws + WS_MOD);
    bf16* Hb = (bf16*)(F.ws + WS_H); bf16* Ub = (bf16*)(F.ws + WS_U);
    bf16* QDb = (bf16*)(F.ws + WS_QD); bf16* KDb = (bf16*)(F.ws + WS_KD); bf16* Vb = (bf16*)(F.ws + WS_V); bf16* SGb = (bf16*)(F.ws + WS_SG);
    bf16* Yb = (bf16*)(F.ws + WS_Y); bf16* Zb = (bf16*)(F.ws + WS_Z); bf16* Sb = (bf16*)(F.ws + WS_S);
    const float* dec = (const float*)(F.ws + WS_DEC);

    if (PH_ON) prologue_phase(F, in);
    PH_END;

    for (int L = 0; L < DEPTH; ++L) {
        const float* mod_t = mod + (size_t)(L * 2 + 0) * BATCH * (3 * D);
        const float* mod_m = mod + (size_t)(L * 2 + 1) * BATCH * (3 * D);
        const float* xin = (L == 0) ? in.x : X;
        const int lp = L >> 1;
        if ((L & 1) == 0) {
            if (PH_ON) pool_phase(F, xin, Hb, in.norm_g + (size_t)(L * 2 + 0) * D, mod_t);
            PH_END;
            if (PH_ON) {
                pg8::Gemm g{Hb, (const bf16*)(F.ws + WS_WPOOL) + (size_t)lp * NPG * PG * PG, M, D, PG, D, PG, 1, PG};
                pg8::StaticOrder S; S.init(M, D, F.G, (int)blockIdx.x);
                EpiRes E{xin, X, mod_t + 2 * D, 3 * D, in.pool_scale + (size_t)lp * D};
                pg8::gemm_phase<EpiRes, pg8::StaticOrder, true, true>(F.lds, g, S, E);
            }
            PH_END;
        } else {
            if (PH_ON) norm_phase(F, X, Hb, in.norm_g + (size_t)(L * 2 + 0) * D, mod_t);
            PH_END;
            if (PH_ON) {
                pg8::Gemm g{Hb, (const bf16*)(F.ws + WS_WIN) + (size_t)lp * D * NPROJ, M, NPROJ, D, D, D, 0, 0};
                pg8::StaticOrder S; S.init(M, NPROJ, F.G, (int)blockIdx.x);
                EpiProj E{QDb, KDb, Vb, SGb, (const float*)(F.ws + WS_COS), (const float*)(F.ws + WS_SIN), dec};
                pg8::gemm_phase<EpiProj, pg8::StaticOrder, true, true>(F.lds, g, S, E);
            }
            PH_END;
            if (PH_ON) s_phase(F, QDb, KDb, Sb, dec);
            PH_END;
            if (PH_ON) chain_phase(F, QDb, KDb, Vb, Sb, Yb, dec);
            PH_END;
            if (PH_ON) gn_phase(F, Yb, SGb, Zb);
            PH_END;
            if (PH_ON) {
                pg8::Gemm g{Zb, (const bf16*)(F.ws + WS_WOUT) + (size_t)lp * VD * D, M, D, VD, VD, VD, 0, 0};
                pg8::StaticOrder S; S.init(M, D, F.G, (int)blockIdx.x);
                EpiRes E{X, X, mod_t + 2 * D, 3 * D, nullptr};
                pg8::gemm_phase<EpiRes, pg8::StaticOrder, true, true>(F.lds, g, S, E);
            }
            PH_END;
        }
        if (PH_ON) norm_phase(F, X, Hb, in.norm_g + (size_t)(L * 2 + 1) * D, mod_m);
        PH_END;
        if (PH_ON) {
            pg8::Gemm g{Hb, (const bf16*)(F.ws + WS_W1) + (size_t)L * D * FF, M, FF, D, D, D, 0, 0};
            pg8::StaticOrder S; S.init(M, FF, F.G, (int)blockIdx.x);
            EpiSq E{Ub, FF};
            pg8::gemm_phase<EpiSq, pg8::StaticOrder, true, true>(F.lds, g, S, E);
        }
        PH_END;
        if (PH_ON) {
            pg8::Gemm g{Ub, (const bf16*)(F.ws + WS_W2) + (size_t)L * FF * D, M, D, FF, FF, FF, 0, 0};
            pg8::StaticOrder S; S.init(M, D, F.G, (int)blockIdx.x);
            EpiRes E{X, X, mod_m + 2 * D, 3 * D, nullptr};
            pg8::gemm_phase<EpiRes, pg8::StaticOrder, true, true>(F.lds, g, S, E);
        }
        PH_END;
    }
    if (PH_ON) final_norm_phase(F, X, X, in.final_g);
    PH_END;
#undef PH_ON
#undef PH_END
}
constexpr int N_PHASES = 1 + 2 * (5 + 9) + 1;

extern "C" void kernel_launch(void* const* d_in, const int* in_sizes, int n_in, void* d_out, int out_size, void* d_ws, size_t ws_size, hipStream_t stream) {
    static int grid = 0;
    if (grid == 0) {
        if (n_in != 12 || in_sizes[0] != M * D || out_size != M * D || ws_size < WS_END) { fprintf(stderr, "kernel_launch: unexpected shapes (n_in %d, in0 %d, out %d, ws %zu)\n", n_in, n_in > 0 ? in_sizes[0] : -1, out_size, ws_size); grid = -1; return; }
        int dev = 0, cus = 0, per_cu = 0;
        if (hipGetDevice(&dev) != hipSuccess || hipDeviceGetAttribute(&cus, hipDeviceAttributeMultiprocessorCount, dev) != hipSuccess) { grid = -1; return; }
        if (hipFuncSetAttribute((const void*)fwd, hipFuncAttributeMaxDynamicSharedMemorySize, LDS_BYTES) != hipSuccess) { fprintf(stderr, "kernel_launch: hipFuncSetAttribute failed\n"); grid = -1; return; }
        if (hipOccupancyMaxActiveBlocksPerMultiprocessor(&per_cu, (const void*)fwd, NTHR, LDS_BYTES) != hipSuccess || per_cu < 1) fprintf(stderr, "kernel_launch: occupancy query reports %d\n", per_cu);
        (void)hipGetLastError();
        grid = cus;
    }
    if (grid < 0) return;
    if (hipMemsetAsync((char*)d_ws + WS_CTL, 0, CTL_ZERO_BYTES, stream) != hipSuccess) return;
    Args a{};
    for (int i = 0; i < 12; ++i) a.in[i] = (const float*)d_in[i];
    a.out = (float*)d_out; a.ws = (unsigned char*)d_ws;
#if MK_PER_PHASE
    for (int p = 0; p < N_PHASES; ++p) { a.ph_lo = p; a.ph_hi = p + 1; hipLaunchKernelGGL(fwd, dim3(grid), dim3(NTHR), LDS_BYTES, stream, a); }
#else
    a.ph_lo = 0; a.ph_hi = N_PHASES;
    hipLaunchKernelGGL(fwd, dim3(grid), dim3(NTHR), LDS_BYTES, stream, a);
#endif
    const hipError_t le = hipPeekAtLastError();
    if (le != hipSuccess) fprintf(stderr, "kernel_launch: launch failed: %s\n", hipGetErrorName(le));
}
```

```cpp
#include <hip/hip_runtime.h>
#include <cstdio>
#include <cstdint>

#ifndef MK_PER_PHASE
#define MK_PER_PHASE 0
#endif
#define PROBE_DUP 0
#define PROBE_CHAIN_VAR 0
#define PROBE_LEAK 0
#define REP(bit) for (int rep_ = ((PROBE_DUP) & (bit)) ? 0 : 1; rep_ < 2; ++rep_)

namespace pg8 {
#define PG8_LAS __attribute__((address_space(3)))
typedef unsigned short bf16_t;
typedef short bf16x8 __attribute__((ext_vector_type(8)));
typedef float f32x4 __attribute__((ext_vector_type(4)));
typedef unsigned u32x4 __attribute__((ext_vector_type(4)));
constexpr int BM = 256, BK = 64, HALF = 128, HTB = HALF * BK * 2  , STAGE_BYTES = 8 * HTB, NXCD = 8, WGM = 8;

__host__ __device__ __forceinline__ int lds_byte(int r, int c) { const int st = (r >> 4) * 2 + (c >> 5), rr = r & 15, cc = c & 31, ob = rr * 64 + cc * 2; return st * 1024 + (ob ^ (((ob >> 9) & 1) << 5)); }
__host__ __device__ __forceinline__ void stage_rc(int b, int& R, int& C) { const int st = b / 1024, sb = b % 1024, swz = sb ^ (((sb >> 9) & 1) << 5); R = (st >> 1) * 16 + swz / 64; C = (st & 1) * 32 + (swz % 64) / 2; }
__host__ __device__ __forceinline__ int perm32(int rho) { const int n = rho >> 4, i = rho & 15; return 8 * (i >> 2) + 4 * n + (i & 3); }

struct Unit { int pm, pn; };
struct Gemm { const bf16_t* A; const bf16_t* Bt; int M, N, K, lda, ldb, grp_shift, grp_koff; };

struct StaticOrder {
    int nM, nN, nwg, G, c;
    __host__ __device__ void init(int M, int N, int G_, int c_) { nM = M / BM; nN = N / BM; nwg = nM * nN; G = G_; c = c_; }
    __host__ __device__ bool next(int i, Unit& u) const {
        const long L = (long)i * G + c; if (L >= nwg) return false;
        int wgid = (int)L; { const int q = nwg / NXCD, r = nwg % NXCD, xcd = wgid % NXCD, off = wgid / NXCD; wgid = (xcd < r ? xcd * (q + 1) : r * (q + 1) + (xcd - r) * q) + off; }
        const int nig = WGM * nN, gid = wgid / nig, fm = gid * WGM, gsz = (nM - fm) < WGM ? (nM - fm) : WGM;
        u.pm = fm + ((wgid % nig) % gsz); u.pn = (wgid % nig) / gsz; return true;
    }
    __device__ __forceinline__ void a_ready(const Unit&) const {}
    __device__ __forceinline__ void done(const Unit&) const {}
};

__device__ __forceinline__ unsigned cvt_pk_bf16(float lo, float hi) { unsigned r; asm volatile("v_cvt_pk_bf16_f32 %0, %1, %2" : "=v"(r) : "v"(lo), "v"(hi)); return r; }

template <class Epi, class Sched, bool ALIGN_EPI = false, bool SP2 = false>
__device__ __forceinline__ void gemm_phase(PG8_LAS unsigned char* lds, const Gemm g, const Sched& S, const Epi& E) {
    int tid_ = threadIdx.x; asm volatile("" : "+v"(tid_));
    const int tid = tid_, wid = __builtin_amdgcn_readfirstlane(tid >> 6), lane = tid & 63, wr = wid >> 2, wc = wid & 3, fr = lane & 15, fq = lane >> 4;
    const int K = g.K, nt = K / BK;
    unsigned voffA[2], voffB[2];
#pragma unroll
    for (int i = 0; i < 2; ++i) { int R, C; stage_rc(tid * 16 + i * 8192, R, C); const int Rb = Epi::PERM ? ((R & ~31) + perm32(R & 31)) : R;
        voffA[i] = (unsigned)(R * g.lda + C) * 2u; voffB[i] = (unsigned)(Rb * g.ldb + C) * 2u; }
    const size_t kstep = (size_t)(BK * 2);
    const size_t hstepA = (size_t)HALF * g.lda * 2, hstepB = (size_t)HALF * g.ldb * 2;
    const size_t tstepA = 2 * hstepA, tstepB = 2 * hstepB;
    const unsigned ldsw = (unsigned)wid * 1024u;
    const int aoff = lds_byte(wr * 64 + fr, fq * 8), boff = lds_byte(wc * 32 + fr, fq * 8);
#define PG8_APTR(u) ((const char*)g.A + (size_t)(u).pm * tstepA + (size_t)(((u).pn >> g.grp_shift) * g.grp_koff) * 2)
#define PG8_BPTR(u) ((const char*)g.Bt + (size_t)(u).pn * tstepB)
#define PG8_SA(b, h) (((b) * 2 + (h)) * HTB)
#define PG8_SB(b, h) ((4 + (b) * 2 + (h)) * HTB)
#define PG8_STAGE(bufoff, gbase, voff) do { _Pragma("unroll") for (int _i = 0; _i < 2; ++_i) \
        __builtin_amdgcn_global_load_lds((const unsigned*)((const char*)(gbase) + (voff)[_i]), (PG8_LAS unsigned*)(lds + (bufoff) + ldsw + _i * 8192), 16, 0, 0); } while (0)
#define PG8_LDA(dst, b, h) do { _Pragma("unroll") for (int m = 0; m < 4; ++m) _Pragma("unroll") for (int k = 0; k < 2; ++k) dst[m][k] = *(const PG8_LAS bf16x8*)(lds + PG8_SA(b, h) + aoff + m * 2048 + k * 1024); } while (0)
#define PG8_LDB(dst, b, h) do { _Pragma("unroll") for (int n = 0; n < 2; ++n) _Pragma("unroll") for (int k = 0; k < 2; ++k) dst[n][k] = *(const PG8_LAS bf16x8*)(lds + PG8_SB(b, h) + boff + n * 2048 + k * 1024); } while (0)
#define PG8_MMA(ai, bj, At, Bt) do { __builtin_amdgcn_s_setprio(1); _Pragma("unroll") for (int m = 0; m < 4; ++m) _Pragma("unroll") for (int n = 0; n < 2; ++n) _Pragma("unroll") for (int k = 0; k < 2; ++k) \
        acc[ai][bj][m][n] = __builtin_amdgcn_mfma_f32_16x16x32_bf16(Bt[n][k], At[m][k], acc[ai][bj][m][n], 0, 0, 0); __builtin_amdgcn_s_setprio(0); } while (0)
#define PG8_WAIT_V(n) asm volatile("s_waitcnt vmcnt(" #n ")" ::: "memory")
#define PG8_WAIT_L(n) asm volatile("s_waitcnt lgkmcnt(" #n ")" ::: "memory")
#define PG8_BAR __builtin_amdgcn_s_barrier()
#define PG8_SCHED __builtin_amdgcn_sched_barrier(0)
    Unit cur, nxt; int ui = 0;
    if (!S.next(0, cur)) return;
    f32x4 acc[2][2][4][2];
#pragma unroll
    for (int a = 0; a < 2; ++a)
#pragma unroll
        for (int b = 0; b < 2; ++b)
#pragma unroll
            for (int m = 0; m < 4; ++m)
#pragma unroll
                for (int n = 0; n < 2; ++n) acc[a][b][m][n] = (f32x4){0.f, 0.f, 0.f, 0.f};
    bf16x8 At[4][2], B0[2][2], B1[2][2];
    const char* cA = PG8_APTR(cur); const char* cB = PG8_BPTR(cur);
    S.a_ready(cur);
    if constexpr (SP2) {
        PG8_STAGE(PG8_SB(0, 0), cB, voffB); PG8_STAGE(PG8_SB(0, 1), cB + hstepB, voffB); PG8_STAGE(PG8_SA(0, 0), cA, voffA); PG8_STAGE(PG8_SA(0, 1), cA + hstepA, voffA);
        if (wr == 1) PG8_BAR;
        PG8_WAIT_V(2); PG8_BAR;
        PG8_STAGE(PG8_SB(1, 0), cB + kstep, voffB); PG8_STAGE(PG8_SA(1, 0), cA + kstep, voffA); PG8_STAGE(PG8_SB(1, 1), cB + hstepB + kstep, voffB);
        PG8_WAIT_V(6); PG8_BAR;
    } else {
        PG8_STAGE(PG8_SB(0, 0), cB, voffB); PG8_STAGE(PG8_SA(0, 0), cA, voffA); PG8_STAGE(PG8_SB(0, 1), cB + hstepB, voffB); PG8_STAGE(PG8_SA(0, 1), cA + hstepA, voffA);
        if (wr == 1) PG8_BAR;
        PG8_WAIT_V(4); PG8_BAR;
        PG8_STAGE(PG8_SB(1, 0), cB + kstep, voffB); PG8_STAGE(PG8_SA(1, 0), cA + kstep, voffA); PG8_STAGE(PG8_SB(1, 1), cB + hstepB + kstep, voffB);
        PG8_WAIT_V(6); PG8_BAR;
    }
    for (;;) {
        const bool has_next = S.next(ui + 1, nxt);
        const char* nA = has_next ? PG8_APTR(nxt) : cA; const char* nB = has_next ? PG8_BPTR(nxt) : cB;
        for (int t = 0; t < nt; t += 2) {
            const bool last = (t == nt - 2);
            const char* a1 = cA + (size_t)(t + 1) * kstep;
            const char* a2 = last ? nA : cA + (size_t)(t + 2) * kstep; const char* b2 = last ? nB : cB + (size_t)(t + 2) * kstep;
            const char* a3 = a2 + kstep; const char* b3 = b2 + kstep;
            if (last && has_next) S.a_ready(nxt);
            if constexpr (SP2) {
            PG8_LDB(B0, 0, 0); PG8_LDB(B1, 0, 1); PG8_SCHED; PG8_LDA(At, 0, 0); PG8_STAGE(PG8_SA(1, 1), a1 + hstepA, voffA);
            PG8_WAIT_V(8); PG8_WAIT_L(0); PG8_BAR; PG8_MMA(0, 0, At, B0); PG8_MMA(0, 1, At, B1); PG8_BAR; PG8_SCHED;
            PG8_LDA(At, 0, 1); PG8_STAGE(PG8_SB(0, 0), b2, voffB); PG8_STAGE(PG8_SB(0, 1), b2 + hstepB, voffB); PG8_STAGE(PG8_SA(0, 0), a2, voffA);
            PG8_WAIT_V(8); PG8_WAIT_L(0); PG8_BAR; PG8_MMA(1, 0, At, B0); PG8_MMA(1, 1, At, B1); PG8_BAR; PG8_SCHED;
            PG8_LDB(B0, 1, 0); PG8_LDB(B1, 1, 1); PG8_SCHED; PG8_LDA(At, 1, 0); PG8_STAGE(PG8_SA(0, 1), a2 + hstepA, voffA);
            PG8_WAIT_V(8); PG8_WAIT_L(0); PG8_BAR; PG8_MMA(0, 0, At, B0); PG8_MMA(0, 1, At, B1); PG8_BAR; PG8_SCHED;
            PG8_LDA(At, 1, 1); PG8_STAGE(PG8_SB(1, 0), b3, voffB); PG8_STAGE(PG8_SB(1, 1), b3 + hstepB, voffB); PG8_STAGE(PG8_SA(1, 0), a3, voffA);
            PG8_WAIT_V(8); PG8_WAIT_L(0); PG8_BAR; PG8_MMA(1, 0, At, B0); PG8_MMA(1, 1, At, B1); PG8_BAR; PG8_SCHED;
            } else {
            PG8_LDB(B0, 0, 0); PG8_SCHED; PG8_LDA(At, 0, 0); PG8_STAGE(PG8_SA(1, 1), a1 + hstepA, voffA);
            PG8_WAIT_L(8); PG8_BAR; PG8_WAIT_L(0); PG8_MMA(0, 0, At, B0); PG8_BAR; PG8_SCHED;
            PG8_LDB(B1, 0, 1); PG8_STAGE(PG8_SB(0, 0), b2, voffB);
            PG8_BAR; PG8_WAIT_L(0); PG8_MMA(0, 1, At, B1); PG8_BAR;
            PG8_LDA(At, 0, 1); PG8_STAGE(PG8_SA(0, 0), a2, voffA);
            PG8_BAR; PG8_WAIT_L(0); PG8_MMA(1, 0, At, B0); PG8_BAR; PG8_SCHED;
            PG8_STAGE(PG8_SB(0, 1), b2 + hstepB, voffB);
            PG8_WAIT_V(6); PG8_BAR; PG8_MMA(1, 1, At, B1); PG8_BAR;
            PG8_LDB(B0, 1, 0); PG8_SCHED; PG8_LDA(At, 1, 0); PG8_STAGE(PG8_SA(0, 1), a2 + hstepA, voffA);
            PG8_WAIT_L(8); PG8_BAR; PG8_WAIT_L(0); PG8_MMA(0, 0, At, B0); PG8_BAR; PG8_SCHED;
            PG8_LDB(B1, 1, 1); PG8_STAGE(PG8_SB(1, 0), b3, voffB);
            PG8_BAR; PG8_WAIT_L(0); PG8_MMA(0, 1, At, B1); PG8_BAR;
            PG8_LDA(At, 1, 1); PG8_STAGE(PG8_SA(1, 0), a3, voffA);
            PG8_BAR; PG8_WAIT_L(0); PG8_MMA(1, 0, At, B0); PG8_BAR; PG8_SCHED;
            PG8_STAGE(PG8_SB(1, 1), b3 + hstepB, voffB);
            PG8_WAIT_V(6); PG8_BAR; PG8_MMA(1, 1, At, B1); PG8_BAR;
            }
        }
        if constexpr (ALIGN_EPI) { if (wr == 0) PG8_BAR; }
        E(acc, cur, wr, wc, fr, fq);
        if (!has_next) break;
#pragma unroll
        for (int a = 0; a < 2; ++a)
#pragma unroll
            for (int b = 0; b < 2; ++b)
#pragma unroll
                for (int m = 0; m < 4; ++m)
#pragma unroll
                    for (int n = 0; n < 2; ++n) acc[a][b][m][n] = (f32x4){0.f, 0.f, 0.f, 0.f};
        cur = nxt; cA = nA; cB = nB; ++ui;
        if constexpr (ALIGN_EPI) { if (wr == 1) PG8_BAR; }
    }
    PG8_WAIT_V(0);
    if constexpr (!ALIGN_EPI) { if (wr == 0) PG8_BAR; }
    PG8_BAR;
#undef PG8_APTR
#undef PG8_BPTR
#undef PG8_SA
#undef PG8_SB
#undef PG8_STAGE
#undef PG8_LDA
#undef PG8_LDB
#undef PG8_MMA
#undef PG8_WAIT_V
#undef PG8_WAIT_L
#undef PG8_BAR
#undef PG8_SCHED
}
}

constexpr int NWAVES = 8, NTHR = NWAVES * 64;
constexpr int BATCH = 2, SEQ = 4096, D = 2048, DEPTH = 4, M = BATCH * SEQ;
constexpr int NPG = 4, PG = 512;
constexpr int RH = 8, DK = 256, DV = 512, VD = 4096, RC = 128, NCH = SEQ / RC;
constexpr int NPROJ = 2 * D + 2 * VD;
constexpr int FF = 4 * D;
constexpr float EPS = 1e-6f;

constexpr size_t MiB = 1u << 20;
constexpr size_t WS_CTL = 0, CTL_ZERO_BYTES = 64 * 1024;
constexpr size_t WS_MOD = 1 * MiB;
constexpr size_t WS_DEC = 2 * MiB;
constexpr size_t WS_COS = 3 * MiB, WS_SIN = 5 * MiB;
constexpr size_t WS_WPOOL = 8 * MiB;
constexpr size_t WS_WIN = 12 * MiB;
constexpr size_t WS_WOUT = 108 * MiB;
constexpr size_t WS_W1 = 140 * MiB;
constexpr size_t WS_W2 = 268 * MiB;
constexpr size_t WS_H = 396 * MiB;
constexpr size_t WS_U = 428 * MiB;
constexpr size_t WS_QD = 556 * MiB;
constexpr size_t WS_KD = 588 * MiB;
constexpr size_t WS_V = 620 * MiB;
constexpr size_t WS_SG = 684 * MiB;
constexpr size_t WS_Y = 748 * MiB;
constexpr size_t WS_Z = 812 * MiB;
constexpr size_t WS_S = 876 * MiB;
constexpr size_t WS_DUMMY = 892 * MiB;
constexpr size_t WS_END = 956 * MiB;
constexpr int CW_BAR = 4096;

constexpr int RING_BYTES = 131072;
constexpr int LDSCTL_OFF = RING_BYTES, MISC_OFF = LDSCTL_OFF + 320;
constexpr int LDS_BYTES = 147456;

#define GAS __attribute__((address_space(1)))
#define LAS __attribute__((address_space(3)))
typedef unsigned short bf16;
typedef unsigned v4u __attribute__((ext_vector_type(4)));
typedef unsigned v2u __attribute__((ext_vector_type(2)));
typedef float f32x4 __attribute__((ext_vector_type(4)));
typedef float f32x2 __attribute__((ext_vector_type(2)));
typedef short bf16x8 __attribute__((ext_vector_type(8)));
typedef short bf16x4 __attribute__((ext_vector_type(4)));
typedef GAS unsigned gu32;
#define RLX_AGENT __ATOMIC_RELAXED, __HIP_MEMORY_SCOPE_AGENT
__device__ __forceinline__ unsigned f2bf(float f) { unsigned u = __builtin_bit_cast(unsigned, f); return (u + 0x7fffu + ((u >> 16) & 1u)) >> 16; }
__device__ __forceinline__ unsigned pk2(float lo, float hi) { return f2bf(lo) | (f2bf(hi) << 16); }
__device__ __forceinline__ float bf2f(unsigned short b) { return __builtin_bit_cast(float, ((unsigned)b) << 16); }
__device__ __forceinline__ float bflo(unsigned w) { return __builtin_bit_cast(float, w << 16); }
__device__ __forceinline__ float bfhi(unsigned w) { return __builtin_bit_cast(float, w & 0xffff0000u); }

#define XB_TMO      128
#define XB_XCNT(j)  (256  + 64 * (j))
#define XB_XSUB(j)  (1280 + 64 * (j))
#define XB_XGEN(j)  (2304 + 64 * (j))
#define XB_TOP      3328
#define XB_TOPGEN   3392
#define XCD_BAR_WORDS 3456
#define XB_SPIN_CAP (1u << 18)
__device__ __forceinline__ unsigned xb_ld(unsigned* p)              { return __hip_atomic_load(p, __ATOMIC_RELAXED, __HIP_MEMORY_SCOPE_AGENT); }
__device__ __forceinline__ unsigned xb_add(unsigned* p, unsigned v) { return __hip_atomic_fetch_add(p, v, __ATOMIC_RELAXED, __HIP_MEMORY_SCOPE_AGENT); }
__device__ __forceinline__ unsigned xb_xcc_id() { return (unsigned)__builtin_amdgcn_s_getreg((3 << 11) | 20) & 0xFu; }
#define XB_SPIN(cond, bar) do { unsigned _sp = 0; while (cond) { __builtin_amdgcn_s_sleep(1); \
    if ((++_sp & 255u) == 0u) { if (xb_ld(&(bar)[XB_TMO])) break; if (_sp > XB_SPIN_CAP) { atomicAdd(&(bar)[XB_TMO], 1u); break; } } } } while (0)
struct XcdBarrier { unsigned* bar; unsigned x; volatile LAS unsigned* st; };
__device__ __forceinline__ XcdBarrier xcd_barrier_post(unsigned* bar, volatile LAS unsigned* st) {
    XcdBarrier b; b.bar = bar; b.x = xb_xcc_id(); b.st = st;
    if (threadIdx.x == 0) (void)xb_add(&bar[XB_XCNT(b.x)], 1u);
    return b;
}
__device__ __forceinline__ void xcd_barrier_complete(unsigned* bar, unsigned x, unsigned& nloc, unsigned& nx) {
    const unsigned G = gridDim.x * gridDim.y * gridDim.z;
    unsigned sum, cnt, mine, sp = 0u;
    for (;;) {
        sum = 0u; cnt = 0u; mine = 0u;
#pragma unroll
        for (unsigned j = 0; j < 16; ++j) { const unsigned c = xb_ld(&bar[XB_XCNT(j)]); sum += c; cnt += (c > 0u) ? 1u : 0u; mine = (j == x) ? c : mine; }
        if (sum == G) break;
        __builtin_amdgcn_s_sleep(1);
        if ((++sp & 255u) == 0u) { if (xb_ld(&bar[XB_TMO])) break; if (sp > XB_SPIN_CAP) { atomicAdd(&bar[XB_TMO], 1u); break; } }
    }
    nloc = mine > 0u ? mine : 1u; nx = cnt > 0u ? cnt : 1u;
}
__device__ __forceinline__ void xcd_barrier(const XcdBarrier& b) {
    asm volatile("s_waitcnt vmcnt(0)" ::: "memory");
    __syncthreads();
    if (threadIdx.x == 0) {
        unsigned* bar = b.bar;
        __builtin_amdgcn_s_waitcnt(0);
        unsigned nloc = b.st[0], nx = b.st[1];
        if (nloc == 0u) { xcd_barrier_complete(bar, b.x, nloc, nx); b.st[0] = nloc; b.st[1] = nx; }
        const unsigned old = xb_add(&bar[XB_XSUB(b.x)], 1u);
        const unsigned gen = old / nloc;
        if (old + 1u == (gen + 1u) * nloc) {
            __builtin_amdgcn_fence(__ATOMIC_RELEASE, "agent");
            asm volatile("s_waitcnt vmcnt(0)" ::: "memory");
            const unsigned og = xb_add(&bar[XB_TOP], 1u);
            const unsigned tg = og / nx;
            if (og + 1u == (tg + 1u) * nx) xb_add(&bar[XB_TOPGEN], 1u);
            else XB_SPIN(xb_ld(&bar[XB_TOPGEN]) == tg, bar);
            __builtin_amdgcn_fence(__ATOMIC_ACQUIRE, "agent");
            xb_add(&bar[XB_XGEN(b.x)], 1u);
            asm volatile("s_waitcnt vmcnt(0)" ::: "memory");
        } else {
            XB_SPIN(xb_ld(&bar[XB_XGEN(b.x)]) == gen, bar);
            __builtin_amdgcn_fence(__ATOMIC_ACQUIRE, "agent");
            asm volatile("s_waitcnt vmcnt(0)" ::: "memory");
        }
    }
    __syncthreads();
}

struct Frame {
    LAS unsigned char* lds;
    int tid, lane, wave, vcu, G;
    unsigned char* ws;
    __device__ __forceinline__ void refresh() { int t = threadIdx.x; asm volatile("" : "+v"(t)); tid = t; lane = t & 63; wave = __builtin_amdgcn_readfirstlane(t >> 6); }
};
__device__ __forceinline__ float wave_sum(float v) {
#pragma unroll
    for (int o = 1; o < 64; o <<= 1) v += __shfl_xor(v, o);
    return v;
}

using pg8::Unit; using pg8::BM; using pg8::HALF; using pg8::bf16_t; using pg8::u32x4; using pg8::cvt_pk_bf16;
struct EpiRes {
    static constexpr bool PERM = false;
    const float* xin; float* xout; const float* gate; int gstride; const float* ls;
    __device__ __forceinline__ void operator()(const f32x4 (&acc)[2][2][4][2], const Unit& u, int wr, int wc, int fr, int fq) const {
        const int row0 = u.pm * BM + wr * 64 + fr, col0 = u.pn * BM + wc * 32 + 4 * fq;
        const int b = (u.pm * BM) / SEQ;
        f32x4 gv[2][2];
#pragma unroll
        for (int bj = 0; bj < 2; ++bj)
#pragma unroll
            for (int n = 0; n < 2; ++n) { const int c = col0 + bj * HALF + n * 16; f32x4 gg = *(const f32x4*)(gate + (size_t)b * gstride + c); if (ls) gg = gg * *(const f32x4*)(ls + c); gv[bj][n] = gg; }
#pragma unroll
        for (int ai = 0; ai < 2; ++ai)
#pragma unroll
            for (int m = 0; m < 4; ++m) { const size_t off = (size_t)(row0 + ai * HALF + m * 16) * D + col0;
#pragma unroll
                for (int bj = 0; bj < 2; ++bj)
#pragma unroll
                    for (int n = 0; n < 2; ++n) { const f32x4 xi = *(const f32x4*)(xin + off + bj * HALF + n * 16); *(f32x4*)(xout + off + bj * HALF + n * 16) = xi + gv[bj][n] * acc[ai][bj][m][n]; }
                if (m & 1) asm volatile("" ::: "memory"); }
    }
};
struct EpiSq {
    static constexpr bool PERM = true;
    bf16_t* O; int ldc;
    __device__ __forceinline__ void operator()(const f32x4 (&acc)[2][2][4][2], const Unit& u, int wr, int wc, int fr, int fq) const {
        const int row0 = u.pm * BM + wr * 64 + fr, col0 = u.pn * BM + wc * 32 + 8 * fq;
#pragma unroll
        for (int ai = 0; ai < 2; ++ai)
#pragma unroll
            for (int m = 0; m < 4; ++m) { bf16_t* rowp = O + (size_t)(row0 + ai * HALF + m * 16) * ldc + col0;
#pragma unroll
                for (int bj = 0; bj < 2; ++bj) { f32x4 v0 = acc[ai][bj][m][0], v1 = acc[ai][bj][m][1];
#pragma unroll
                    for (int j = 0; j < 4; ++j) { const float a0 = fmaxf(v0[j], 0.f), a1 = fmaxf(v1[j], 0.f); v0[j] = a0 * a0; v1[j] = a1 * a1; }
                    u32x4 w; w.x = cvt_pk_bf16(v0[0], v0[1]); w.y = cvt_pk_bf16(v0[2], v0[3]); w.z = cvt_pk_bf16(v1[0], v1[1]); w.w = cvt_pk_bf16(v1[2], v1[3]);
                    *(u32x4*)(rowp + bj * HALF) = w; } }
    }
};
struct EpiProj {
    static constexpr bool PERM = true;
    bf16_t *QD, *KD, *V, *SG; const float *cosT, *sinT, *dec;
    __device__ __forceinline__ void operator()(const f32x4 (&acc)[2][2][4][2], const Unit& u, int wr, int wc, int fr, int fq) const {
        const int row0 = u.pm * BM + wr * 64 + fr, c0 = wc * 32 + 8 * fq;
        if (u.pn < 16) {
            const int h = u.pn & 7; const bool isk = u.pn >= 8;
            char* base = (char*)(isk ? KD : QD) + (size_t)(8 * h + wc) * 1024 + (fq * 16 + fr) * 16;
            const float* dtab = dec + (isk ? 1024 : 0) + h * RC;
#pragma unroll
            for (int ai = 0; ai < 2; ++ai)
#pragma unroll
                for (int m = 0; m < 4; ++m) { const int r = row0 + ai * HALF + m * 16; const int pos = r & (SEQ - 1); const float dc = dtab[r & (RC - 1)];
#pragma unroll
                    for (int bj = 0; bj < 2; ++bj) { const int pi = (c0 + bj * HALF) >> 1;
                        const f32x4 cs = *(const f32x4*)(cosT + (size_t)pos * 128 + pi), sn = *(const f32x4*)(sinT + (size_t)pos * 128 + pi);
                        const f32x4 v0 = acc[ai][bj][m][0], v1 = acc[ai][bj][m][1];
                        const float o0 = (v0[0] * cs[0] - v0[1] * sn[0]) * dc, o1 = (v0[0] * sn[0] + v0[1] * cs[0]) * dc;
                        const float o2 = (v0[2] * cs[1] - v0[3] * sn[1]) * dc, o3 = (v0[2] * sn[1] + v0[3] * cs[1]) * dc;
                        const float o4 = (v1[0] * cs[2] - v1[1] * sn[2]) * dc, o5 = (v1[0] * sn[2] + v1[1] * cs[2]) * dc;
                        const float o6 = (v1[2] * cs[3] - v1[3] * sn[3]) * dc, o7 = (v1[2] * sn[3] + v1[3] * cs[3]) * dc;
                        u32x4 w; w.x = cvt_pk_bf16(o0, o1); w.y = cvt_pk_bf16(o2, o3); w.z = cvt_pk_bf16(o4, o5); w.w = cvt_pk_bf16(o6, o7);
                        *(u32x4*)(base + (size_t)((r >> 4) * 64 + 4 * bj) * 1024) = w; }
                    if (m & 1) asm volatile("" ::: "memory"); }
        } else {
            const bool isg = u.pn >= 32;
            bf16_t* base = SG + (u.pn - 32) * BM + c0;
            char* vbase = (char*)V + (size_t)((u.pn - 16) * 8 + wc) * 1024 + (fq * 16 + fr) * 16;
#pragma unroll
            for (int ai = 0; ai < 2; ++ai)
#pragma unroll
                for (int m = 0; m < 4; ++m) { const int r = row0 + ai * HALF + m * 16;
#pragma unroll
                    for (int bj = 0; bj < 2; ++bj) { f32x4 v0 = acc[ai][bj][m][0], v1 = acc[ai][bj][m][1];
                        if (isg) {
#pragma unroll
                            for (int j = 0; j < 4; ++j) { v0[j] = v0[j] * __builtin_amdgcn_rcpf(1.0f + __expf(-v0[j])); v1[j] = v1[j] * __builtin_amdgcn_rcpf(1.0f + __expf(-v1[j])); } }
                        u32x4 w; w.x = cvt_pk_bf16(v0[0], v0[1]); w.y = cvt_pk_bf16(v0[2], v0[3]); w.z = cvt_pk_bf16(v1[0], v1[1]); w.w = cvt_pk_bf16(v1[2], v1[3]);
                        if (isg) *(u32x4*)(base + (size_t)r * VD + bj * HALF) = w; else *(u32x4*)(vbase + (size_t)((r >> 4) * 128 + 4 * bj) * 1024) = w; } }
        }
    }
};

__device__ __forceinline__ void p0_transpose_item(const float* W, int K, int N, bf16* WT, LAS float* scr, int item, int lane) {
    const int nblk = N / 32, kb = item / nblk, nb = item % nblk, k0 = 64 * kb, n0 = 32 * nb;
#pragma unroll 8
    for (int i = 0; i < 32; ++i) { const int kk = 2 * i + (lane >> 5); scr[kk * 33 + (lane & 31)] = W[(size_t)(k0 + kk) * N + n0 + (lane & 31)]; }
    asm volatile("s_waitcnt lgkmcnt(0)" ::: "memory");
    const int c = lane & 7;
#pragma unroll
    for (int j = 0; j < 4; ++j) { const int n = (lane >> 3) + 8 * j; const LAS float* s = scr + (8 * c) * 33 + n;
        v4u o; o.x = pk2(s[0 * 33], s[1 * 33]); o.y = pk2(s[2 * 33], s[3 * 33]); o.z = pk2(s[4 * 33], s[5 * 33]); o.w = pk2(s[6 * 33], s[7 * 33]);
        *(v4u*)(WT + (size_t)(n0 + n) * K + k0 + 8 * c) = o; }
    asm volatile("s_waitcnt lgkmcnt(0)" ::: "memory");
}
struct Inputs { const float *x, *c, *ada_w, *ada_b, *norm_g, *pool_w, *pool_scale, *ret_w_in, *ret_w_out, *mlp_w1, *mlp_w2, *final_g; };

__device__ __forceinline__ void prologue_phase(Frame& F, const Inputs& in) {
    F.refresh();
    LAS float* cond = (LAS float*)(F.lds);
    LAS float* red = (LAS float*)(F.lds + 16384);
    for (int i = F.tid; i < BATCH * D; i += NTHR) { const float cv = in.c[i]; cond[i] = cv / (1.0f + expf(-cv)); }
    __syncthreads();
    float* mod = (float*)(F.ws + WS_MOD);
    for (int it = blockIdx.x; it < 8 * 96; it += F.G) {
        const int is = it / 96, col0 = (it % 96) * 64;
        const float* W = in.ada_w + (size_t)is * D * (3 * D) + col0;
        const int rsub = F.lane >> 4, cq = F.lane & 15, d0 = F.wave * 256;
        f32x4 a0 = {0.f, 0.f, 0.f, 0.f}, a1 = {0.f, 0.f, 0.f, 0.f};
#pragma unroll 8
        for (int rr = 0; rr < 256; rr += 4) { const int d = d0 + rr + rsub; const f32x4 wv = *(const f32x4*)(W + (size_t)d * (3 * D) + 4 * cq);
            const float c0 = cond[d], c1 = cond[D + d]; a0 += wv * c0; a1 += wv * c1; }
#pragma unroll
        for (int j = 0; j < 4; ++j) { a0[j] += __shfl_xor(a0[j], 16); a0[j] += __shfl_xor(a0[j], 32); a1[j] += __shfl_xor(a1[j], 16); a1[j] += __shfl_xor(a1[j], 32); }
        if (rsub == 0) { *(LAS f32x4*)(red + (F.wave * 2 + 0) * 64 + 4 * cq) = a0; *(LAS f32x4*)(red + (F.wave * 2 + 1) * 64 + 4 * cq) = a1; }
        __syncthreads();
        if (F.tid < 128) { const int b = F.tid >> 6, cc = F.tid & 63; float s = 0.f;
#pragma unroll
            for (int w = 0; w < 8; ++w) s += red[(w * 2 + b) * 64 + cc];
            mod[((size_t)is * BATCH + b) * (3 * D) + col0 + cc] = s + in.ada_b[(size_t)is * (3 * D) + col0 + cc]; }
        __syncthreads();
    }
    {
        LAS float* scr = (LAS float*)(F.lds + 32768 + F.wave * 8704);
        const int gw = F.vcu * NWAVES + F.wave, NGW = F.G * NWAVES;
        constexpr int I_P = (PG / 64) * (PG / 32), I_IN = (D / 64) * (NPROJ / 32), I_OUT = (VD / 64) * (D / 32), I_1 = (D / 64) * (FF / 32), I_2 = (FF / 64) * (D / 32);
        constexpr int N_P = 8 * I_P, N_IN = 2 * I_IN, N_OUT = 2 * I_OUT, N_1 = 4 * I_1, N_2 = 4 * I_2;
        for (int it = gw; it < N_P + N_IN + N_OUT + N_1 + N_2; it += NGW) {
            int r = it;
            if (r < N_P) { const int mt = r / I_P; p0_transpose_item(in.pool_w + (size_t)mt * PG * PG, PG, PG, (bf16*)(F.ws + WS_WPOOL) + (size_t)mt * PG * PG, scr, r % I_P, F.lane); continue; } r -= N_P;
            if (r < N_IN) { const int mt = r / I_IN; p0_transpose_item(in.ret_w_in + (size_t)mt * D * NPROJ, D, NPROJ, (bf16*)(F.ws + WS_WIN) + (size_t)mt * D * NPROJ, scr, r % I_IN, F.lane); continue; } r -= N_IN;
            if (r < N_OUT) { const int mt = r / I_OUT; p0_transpose_item(in.ret_w_out + (size_t)mt * VD * D, VD, D, (bf16*)(F.ws + WS_WOUT) + (size_t)mt * VD * D, scr, r % I_OUT, F.lane); continue; } r -= N_OUT;
            if (r < N_1) { const int mt = r / I_1; p0_transpose_item(in.mlp_w1 + (size_t)mt * D * FF, D, FF, (bf16*)(F.ws + WS_W1) + (size_t)mt * D * FF, scr, r % I_1, F.lane); continue; } r -= N_1;
            { const int mt = r / I_2; p0_transpose_item(in.mlp_w2 + (size_t)mt * FF * D, FF, D, (bf16*)(F.ws + WS_W2) + (size_t)mt * FF * D, scr, r % I_2, F.lane); }
        }
    }
    {
        float* cosT = (float*)(F.ws + WS_COS); float* sinT = (float*)(F.ws + WS_SIN);
        const int gt = blockIdx.x * NTHR + F.tid, NGT = F.G * NTHR;
        for (int e = gt; e < SEQ * 128; e += NGT) {
            const int pos = e >> 7, i = e & 127;
            double inv = 1.0, bp = 0.9305720409296989792906463164991290590767;
#pragma unroll
            for (int bit = 0; bit < 7; ++bit) { if ((i >> bit) & 1) inv *= bp; bp *= bp; }
            const double ang = (double)pos * inv;
            const double kq = __builtin_rint(ang * 0.6366197723675814);
            double r = __builtin_fma(-kq, 1.5707963267948966, ang); r = __builtin_fma(-kq, 6.123233995736766e-17, r);
            const double r2 = r * r;
            double sp = -1.0 / 1307674368000.0;
            sp = sp * r2 + 1.0 / 6227020800.0; sp = sp * r2 - 1.0 / 39916800.0; sp = sp * r2 + 1.0 / 362880.0; sp = sp * r2 - 1.0 / 5040.0; sp = sp * r2 + 1.0 / 120.0; sp = sp * r2 - 1.0 / 6.0; sp = sp * r2 + 1.0;
            const double sr = sp * r;
            double cp = 1.0 / 20922789888000.0;
            cp = cp * r2 - 1.0 / 87178291200.0; cp = cp * r2 + 1.0 / 479001600.0; cp = cp * r2 - 1.0 / 3628800.0; cp = cp * r2 + 1.0 / 40320.0; cp = cp * r2 - 1.0 / 720.0; cp = cp * r2 + 1.0 / 24.0; cp = cp * r2 - 0.5; cp = cp * r2 + 1.0;
            const int q = ((int)kq) & 3;
            const double sv = (q == 0) ? sr : (q == 1) ? cp : (q == 2) ? -sr : -cp;
            const double cv = (q == 0) ? cp : (q == 1) ? -sr : (q == 2) ? -cp : sr;
            cosT[e] = (float)cv; sinT[e] = (float)sv;
        }
        if (blockIdx.x == 0 && F.tid < RH) {
            float* dec = (float*)(F.ws + WS_DEC); const int h = F.tid;
            const double gam = 1.0 - __builtin_ldexp(1.0, -5 - h);
            double p = 1.0;
            for (int i = 0; i < RC; ++i) { p *= gam; dec[h * RC + i] = (float)p; }
            const double g128 = p;
            double q = 1.0 / 16.0;
            for (int j = RC - 1; j >= 0; --j) { dec[1024 + h * RC + j] = (float)q; q *= gam; }
            dec[2048 + h] = (float)(1.0 / g128);
            dec[2056 + h] = (float)g128;
        }
    }
}

__device__ __forceinline__ void norm_phase(Frame& F, const float* x, bf16* H, const float* g, const float* modp) {
    F.refresh();
    const int gw = F.vcu * NWAVES + F.wave, NGW = F.G * NWAVES;
    for (int r4 = gw; r4 < M / 4; r4 += NGW) {
        const int b = (4 * r4) / SEQ; const float* mp = modp + (size_t)b * (3 * D);
        f32x4 Gc[8], Sc[8];
#pragma unroll
        for (int j = 0; j < 8; ++j) { const int c = 4 * F.lane + 256 * j; const f32x4 gg = *(const f32x4*)(g + c), sc = *(const f32x4*)(mp + D + c); Gc[j] = gg * (sc + 1.0f); Sc[j] = *(const f32x4*)(mp + c); }
        for (int rr = 0; rr < 4; ++rr) {
            const size_t row = (size_t)4 * r4 + rr; const f32x4* xr = (const f32x4*)(x + row * D) + F.lane;
            f32x4 v[8]; float ss = 0.f;
#pragma unroll
            for (int j = 0; j < 8; ++j) { v[j] = xr[64 * j]; ss += (v[j].x * v[j].x + v[j].y * v[j].y) + (v[j].z * v[j].z + v[j].w * v[j].w); }
            const float rstd = 1.0f / sqrtf(wave_sum(ss) * (1.0f / D) + EPS);
            v2u* o = (v2u*)(H + row * D) + F.lane;
#pragma unroll
            for (int j = 0; j < 8; ++j) { const f32x4 hh = v[j] * rstd * Gc[j] + Sc[j]; v2u w; w.x = pk2(hh.x, hh.y); w.y = pk2(hh.z, hh.w); o[64 * j] = w; }
        }
    }
}
__device__ __forceinline__ void final_norm_phase(Frame& F, const float* x, float* out, const float* g) {
    F.refresh();
    const int gw = F.vcu * NWAVES + F.wave, NGW = F.G * NWAVES;
    for (int row = gw; row < M; row += NGW) {
        const f32x4* xr = (const f32x4*)(x + (size_t)row * D) + F.lane;
        f32x4 v[8]; float ss = 0.f;
#pragma unroll
        for (int j = 0; j < 8; ++j) { v[j] = xr[64 * j]; ss += (v[j].x * v[j].x + v[j].y * v[j].y) + (v[j].z * v[j].z + v[j].w * v[j].w); }
        const float rstd = 1.0f / sqrtf(wave_sum(ss) * (1.0f / D) + EPS);
        f32x4* o = (f32x4*)(out + (size_t)row * D) + F.lane;
#pragma unroll
        for (int j = 0; j < 8; ++j) o[64 * j] = v[j] * rstd * *(const f32x4*)(g + 4 * F.lane + 256 * j);
    }
}

__device__ __forceinline__ void pool_phase(Frame& F, const float* x, bf16* P, const float* g, const float* modp) {
    F.refresh();
    LAS float* tile = (LAS float*)(F.lds);
    LAS float* rst = (LAS float*)(F.lds + 47 * 512 * 4);
    for (int blk = blockIdx.x; blk < M / 32; blk += F.G) {
        const int t0 = 32 * blk, b = t0 / SEQ, tb = t0 & (SEQ - 1), halo = (tb == 0) ? 0 : 15;
        const float* mp = modp + (size_t)b * (3 * D);
        for (int tr = 15 - halo + F.wave; tr < 47; tr += 8) {
            const f32x4* xr = (const f32x4*)(x + (size_t)(t0 - 15 + tr) * D) + F.lane; float ss = 0.f;
#pragma unroll
            for (int j = 0; j < 8; ++j) { const f32x4 v = xr[64 * j]; ss += (v.x * v.x + v.y * v.y) + (v.z * v.z + v.w * v.w); }
            ss = wave_sum(ss);
            if (F.lane == 0) rst[tr] = 1.0f / sqrtf(ss * (1.0f / D) + EPS);
        }
        __syncthreads();
        for (int gi = 0; gi < NPG; ++gi) {
            const int c4 = F.tid & 127, cg = gi * PG + 4 * c4;
            const f32x4 Gc = *(const f32x4*)(g + cg) * (*(const f32x4*)(mp + D + cg) + 1.0f), Sc = *(const f32x4*)(mp + cg);
            for (int tr = 15 - halo + (F.tid >> 7); tr < 47; tr += 4) {
                const f32x4 xv = *(const f32x4*)(x + (size_t)(t0 - 15 + tr) * D + cg);
                *(LAS f32x4*)(tile + tr * 512 + 4 * c4) = xv * rst[tr] * Gc + Sc;
            }
            __syncthreads();
            const int w = 2 << gi, cp = F.tid & 255, i0 = (F.tid >> 8) * 16;
            f32x2 s = {0.f, 0.f};
            {
                const int tpos = tb + i0, nwin = (tpos + 1 < w) ? tpos + 1 : w;
                for (int q = 0; q < nwin; ++q) s += *(const LAS f32x2*)(tile + (i0 + 15 - q) * 512 + 2 * cp);
            }
            for (int k = 0; k < 16; ++k) {
                const int i = i0 + k, tr = i + 15, tpos = tb + i;
                if (k > 0) { s += *(const LAS f32x2*)(tile + tr * 512 + 2 * cp); if (tpos >= w) s -= *(const LAS f32x2*)(tile + (tr - w) * 512 + 2 * cp); }
                const int nwin = (tpos + 1 < w) ? tpos + 1 : w;
                const f32x2 hv = *(const LAS f32x2*)(tile + tr * 512 + 2 * cp);
                const float inv = 1.0f / (float)nwin;
                *(unsigned*)(P + (size_t)(t0 + i) * D + gi * PG + 2 * cp) = pk2(s.x * inv - hv.x, s.y * inv - hv.y);
            }
            __syncthreads();
        }
    }
}

__device__ __forceinline__ void s_phase(Frame& F, const bf16* QD, const bf16* KD, bf16* S, const float* dec) {
    F.refresh();
    const int g = F.lane >> 4, l15 = F.lane & 15;
    for (int pair = blockIdx.x; pair < 256; pair += F.G) {
        for (int half = 0; half < 2; ++half) {
            const int item = 2 * pair + half, itile = half ? 7 - F.wave : F.wave;
            const int bh = item >> 5, c = item & 31, b = bh >> 3, h = bh & 7, r0 = b * SEQ + RC * c;
            const float ssc = dec[2048 + h];
            bf16x8 qf[8];
            const char* qblk = (const char*)QD + (size_t)(((r0 >> 4) + itile) * 64 + 8 * h) * 1024 + F.lane * 16;
#pragma unroll
            for (int ks = 0; ks < 8; ++ks) qf[ks] = *(const bf16x8*)(qblk + ks * 1024);
            const int i = 16 * itile + l15;
            char* sblk = (char*)S + (size_t)item * (RC * RC * 2) + (size_t)(itile * 4) * 1024 + ((g >> 1) * 16 + l15) * 16 + 8 * (g & 1);
            for (int jt = 0; jt < 8; ++jt) {
                f32x4 acc = {0.f, 0.f, 0.f, 0.f};
                if (jt <= itile) {
                    const char* kblk = (const char*)KD + (size_t)(((r0 >> 4) + jt) * 64 + 8 * h) * 1024 + F.lane * 16;
#pragma unroll
                    for (int ks = 0; ks < 8; ++ks) { const bf16x8 kf = *(const bf16x8*)(kblk + ks * 1024); acc = __builtin_amdgcn_mfma_f32_16x16x32_bf16(kf, qf[ks], acc, 0, 0, 0); }
                }
                const int jb = 16 * jt + 4 * g;
                float o[4];
#pragma unroll
                for (int rg = 0; rg < 4; ++rg) o[rg] = (jb + rg <= i) ? acc[rg] * ssc : 0.f;
                v2u w; w.x = pk2(o[0], o[1]); w.y = pk2(o[2], o[3]);
                *(v2u*)(sblk + (jt >> 1) * 1024 + (jt & 1) * 512) = w;
            }
        }
    }
}

__device__ __forceinline__ bf16x8 tr_frag(unsigned base, int k0, int c0, int rowb, int lane) {
    const int g = lane >> 4, q = (lane & 15) >> 2, p = lane & 3;
    const unsigned a0 = base + (unsigned)((k0 + 8 * g + q) * rowb + (c0 + 4 * p) * 2), a1 = a0 + 4u * (unsigned)rowb;
    bf16x4 lo, hi;
    asm volatile("ds_read_b64_tr_b16 %0, %2\n\tds_read_b64_tr_b16 %1, %3\n\ts_waitcnt lgkmcnt(0)" : "=&v"(lo), "=&v"(hi) : "v"(a0), "v"(a1) : "memory");
    return __builtin_shufflevector(lo, hi, 0, 1, 2, 3, 4, 5, 6, 7);
}
constexpr int CH_KS_BYTES = 8192;
constexpr int CH_VBYTES = 8192, CH_VIMG = 8 * CH_KS_BYTES;
constexpr int CH_SROW = 528, CH_SBYTES = 32 * CH_SROW, CH_SIMG = CH_VIMG + 2 * CH_VBYTES;
static_assert(CH_SIMG + 2 * CH_SBYTES <= RING_BYTES, "chain LDS map");
#define TRT_ASM "ds_read_b64_tr_b16 %0, %16 offset:0\n\tds_read_b64_tr_b16 %1, %16 offset:64\n\tds_read_b64_tr_b16 %2, %16 offset:512\n\tds_read_b64_tr_b16 %3, %16 offset:576\n\tds_read_b64_tr_b16 %4, %16 offset:2048\n\tds_read_b64_tr_b16 %5, %16 offset:2112\n\tds_read_b64_tr_b16 %6, %16 offset:2560\n\tds_read_b64_tr_b16 %7, %16 offset:2624\n\tds_read_b64_tr_b16 %8, %16 offset:4096\n\tds_read_b64_tr_b16 %9, %16 offset:4160\n\tds_read_b64_tr_b16 %10, %16 offset:4608\n\tds_read_b64_tr_b16 %11, %16 offset:4672\n\tds_read_b64_tr_b16 %12, %16 offset:6144\n\tds_read_b64_tr_b16 %13, %16 offset:6208\n\tds_read_b64_tr_b16 %14, %16 offset:6656\n\tds_read_b64_tr_b16 %15, %16 offset:6720\n\ts_waitcnt lgkmcnt(0)"
#define TR16(ASM, r, addr) asm volatile(ASM : "=&v"(r[0]), "=&v"(r[1]), "=&v"(r[2]), "=&v"(r[3]), "=&v"(r[4]), "=&v"(r[5]), "=&v"(r[6]), "=&v"(r[7]), "=&v"(r[8]), "=&v"(r[9]), "=&v"(r[10]), "=&v"(r[11]), \
        "=&v"(r[12]), "=&v"(r[13]), "=&v"(r[14]), "=&v"(r[15]) : "v"(addr) : "memory")
template <int VAR>
__device__ __forceinline__ void chain_phase(Frame& F, const bf16* QD, const bf16* KD, const bf16* V, const bf16* S, bf16* Y, const float* dec) {
    F.refresh();
    const int g = F.lane >> 4, l15 = F.lane & 15, w = F.wave, q4 = l15 >> 2, p4 = F.lane & 3;
    const unsigned lbase = (unsigned)(size_t)F.lds;
    const unsigned tr_lane = (unsigned)((g >> 1) * 1024 + ((p4 >> 1) * 16 + 8 * (g & 1) + q4) * 16 + 8 * (p4 & 1));
    const unsigned ktr_addr = lbase + (unsigned)(w * CH_KS_BYTES) + tr_lane;
    const unsigned vtr_off = (unsigned)CH_VIMG + tr_lane;
    const int nks = (w >> 1) + 1;
    for (int it = F.vcu; it < 256; it += F.G) {
        const int bh = it >> 4, es = it & 15, b = bh >> 3, h = bh & 7;
        const float cd = dec[2056 + h];
        f32x4 st[2][2];
#pragma unroll
        for (int a = 0; a < 2; ++a)
#pragma unroll
            for (int n = 0; n < 2; ++n) st[a][n] = (f32x4){0.f, 0.f, 0.f, 0.f};
        const char* ksrc = (const char*)KD + (size_t)((b * SEQ / 16) * 64 + 8 * h + w) * 1024 + F.lane * 16;
        const char* vsrc = (const char*)V + (size_t)((b * SEQ / 16 + w) * 128 + 16 * h + es) * 1024 + F.lane * 16;
        const char* qsrc = (const char*)QD + (size_t)((b * SEQ / 16 + w) * 64 + 8 * h) * 1024 + F.lane * 16;
        const char* ssrc = (const char*)S + (size_t)bh * NCH * (RC * RC * 2) + (size_t)(w * 4) * 1024 + F.lane * 16;
        bf16* ydst = Y + (size_t)(b * SEQ + 16 * w + 4 * g) * VD + h * DV + es * 32 + l15;
        v4u kreg[8]; v4u vreg; bf16x8 qf[8], sf[4];
#pragma unroll
        for (int n = 0; n < 8; ++n) kreg[n] = *(const v4u*)(ksrc + (size_t)n * 65536);
        vreg = *(const v4u*)vsrc;
#pragma unroll
        for (int ks = 0; ks < 8; ++ks) qf[ks] = *(const bf16x8*)(qsrc + ks * 1024);
#pragma unroll
        for (int ks = 0; ks < 4; ++ks) if (ks < nks) sf[ks] = *(const bf16x8*)(ssrc + ks * 1024);
        for (int c = 0; c < NCH; ++c) {
            const int buf = c & 1;
#pragma unroll
            for (int n = 0; n < 8; ++n) *(LAS v4u*)(F.lds + w * CH_KS_BYTES + n * 1024 + F.lane * 16) = kreg[n];
            *(LAS v4u*)(F.lds + CH_VIMG + buf * CH_VBYTES + w * 1024 + F.lane * 16) = vreg;
#pragma unroll
            for (int a = 0; a < 2; ++a)
#pragma unroll
                for (int n = 0; n < 2; ++n) { v2u pk; pk.x = pk2(st[a][n][0], st[a][n][1]); pk.y = pk2(st[a][n][2], st[a][n][3]);
                    *(LAS v2u*)(F.lds + CH_SIMG + buf * CH_SBYTES + (16 * n + l15) * CH_SROW + (32 * w + 16 * a + 4 * g) * 2) = pk; }
            if (c + 1 < NCH && VAR != 3) {
#pragma unroll
                for (int n = 0; n < 8; ++n) kreg[n] = *(const v4u*)(ksrc + (size_t)((c + 1) * 8 + n) * 65536);
                vreg = *(const v4u*)(vsrc + (size_t)(c + 1) * 8 * 131072);
            }
            __syncthreads();
            bf16x4 tv[16]; { const unsigned va = lbase + vtr_off + (unsigned)(buf * CH_VBYTES); TR16(TRT_ASM, tv, va); }
            bf16x8 bv[4][2];
#pragma unroll
            for (int ks = 0; ks < 4; ++ks)
#pragma unroll
                for (int n = 0; n < 2; ++n) bv[ks][n] = __builtin_shufflevector(tv[(ks * 2 + n) * 2], tv[(ks * 2 + n) * 2 + 1], 0, 1, 2, 3, 4, 5, 6, 7);
            f32x4 acc[2] = {{0.f, 0.f, 0.f, 0.f}, {0.f, 0.f, 0.f, 0.f}};
#pragma unroll
            for (int ks = 0; ks < 4; ++ks) if (ks < nks) {
#pragma unroll
                for (int n = 0; n < 2; ++n) acc[n] = __builtin_amdgcn_mfma_f32_16x16x32_bf16(sf[ks], bv[ks][n], acc[n], 0, 0, 0); }
#pragma unroll
            for (int ks = 0; ks < 8; ++ks)
#pragma unroll
                for (int n = 0; n < 2; ++n) { const bf16x8 bs = *(const LAS bf16x8*)(F.lds + CH_SIMG + buf * CH_SBYTES + (16 * n + l15) * CH_SROW + (32 * ks + 8 * g) * 2);
                    acc[n] = __builtin_amdgcn_mfma_f32_16x16x32_bf16(qf[ks], bs, acc[n], 0, 0, 0); }
            if (c + 1 < NCH && VAR != 2) {
#pragma unroll
                for (int ks = 0; ks < 8; ++ks) qf[ks] = *(const bf16x8*)(qsrc + (size_t)(c + 1) * 8 * 65536 + ks * 1024);
#pragma unroll
                for (int ks = 0; ks < 4; ++ks) if (ks < nks) sf[ks] = *(const bf16x8*)(ssrc + (size_t)(c + 1) * (RC * RC * 2) + ks * 1024);
            }
#pragma unroll
            for (int a = 0; a < 2; ++a)
#pragma unroll
                for (int n = 0; n < 2; ++n) st[a][n] = st[a][n] * cd;
            bf16x4 tk[16]; TR16(TRT_ASM, tk, ktr_addr);
#pragma unroll
            for (int ks = 0; ks < 4; ++ks)
#pragma unroll
                for (int a = 0; a < 2; ++a) { const bf16x8 ak = __builtin_shufflevector(tk[(ks * 2 + a) * 2], tk[(ks * 2 + a) * 2 + 1], 0, 1, 2, 3, 4, 5, 6, 7);
#pragma unroll
                    for (int n = 0; n < 2; ++n) st[a][n] = __builtin_amdgcn_mfma_f32_16x16x32_bf16(ak, bv[ks][n], st[a][n], 0, 0, 0); }
#pragma unroll
            for (int n = 0; n < 2; ++n)
#pragma unroll
                for (int rg = 0; rg < 4; ++rg) if (VAR != 1 || acc[n][rg] == 123456.789f) ydst[(size_t)(c * RC + rg) * VD + 16 * n] = (bf16)f2bf(acc[n][rg]);
        }
        __syncthreads();
    }
}
__device__ __forceinline__ void gn_phase(Frame& F, const bf16* Y, const bf16* SG, bf16* Z) {
    F.refresh();
    const int gw = F.vcu * NWAVES + F.wave, NGW = F.G * NWAVES;
    for (int p = gw; p < M * RH; p += NGW) {
        const size_t off = (size_t)(p >> 3) * VD + (p & 7) * DV + 8 * F.lane;
        const v4u yw = *(const v4u*)(Y + off), gwv = *(const v4u*)(SG + off);
        float y[8] = {bflo(yw.x), bfhi(yw.x), bflo(yw.y), bfhi(yw.y), bflo(yw.z), bfhi(yw.z), bflo(yw.w), bfhi(yw.w)};
        const float sg[8] = {bflo(gwv.x), bfhi(gwv.x), bflo(gwv.y), bfhi(gwv.y), bflo(gwv.z), bfhi(gwv.z), bflo(gwv.w), bfhi(gwv.w)};
        float s = 0.f;
#pragma unroll
        for (int j = 0; j < 8; ++j) s += y[j];
        const float mu = wave_sum(s) * (1.0f / DV); float q = 0.f;
#pragma unroll
        for (int j = 0; j < 8; ++j) { y[j] -= mu; q += y[j] * y[j]; }
        const float rstd = 1.0f / sqrtf(wave_sum(q) * (1.0f / DV) + EPS);
        v4u o; o.x = pk2(sg[0] * y[0] * rstd, sg[1] * y[1] * rstd); o.y = pk2(sg[2] * y[2] * rstd, sg[3] * y[3] * rstd);
        o.z = pk2(sg[4] * y[4] * rstd, sg[5] * y[5] * rstd); o.w = pk2(sg[6] * y[6] * rstd, sg[7] * y[7] * rstd);
        *(v4u*)(Z + off) = o;
    }
}

struct Args { const float* in[12]; float* out; unsigned char* ws; int ph_lo, ph_hi; };
__global__ void __launch_bounds__(NTHR, 2) fwd(Args args) {
    extern __shared__ __attribute__((aligned(16))) unsigned char lds[];
    Frame F;
    F.lds = (LAS unsigned char*)lds;
    F.tid = threadIdx.x; F.lane = F.tid & 63; F.wave = __builtin_amdgcn_readfirstlane(F.tid >> 6);
    F.G = gridDim.x; { const int bx = blockIdx.x; F.vcu = (F.G % 8 == 0) ? (bx % 8) * (F.G / 8) + bx / 8 : bx; }
    F.ws = args.ws;
    Inputs in; in.x = args.in[0]; in.c = args.in[1]; in.ada_w = args.in[2]; in.ada_b = args.in[3]; in.norm_g = args.in[4]; in.pool_w = args.in[5]; in.pool_scale = args.in[6];
    in.ret_w_in = args.in[7]; in.ret_w_out = args.in[8]; in.mlp_w1 = args.in[9]; in.mlp_w2 = args.in[10]; in.final_g = args.in[11];
    volatile LAS unsigned* MISC = (volatile LAS unsigned*)(F.lds + MISC_OFF);
    for (int u = F.tid; u < (LDS_BYTES - LDSCTL_OFF) / 4; u += NTHR) ((LAS unsigned*)(F.lds + LDSCTL_OFF))[u] = 0u;
    __syncthreads();
    const int lo = args.ph_lo, hi = args.ph_hi;
    XcdBarrier bar; bar.bar = (unsigned*)(F.ws + WS_CTL) + CW_BAR; bar.x = 0; bar.st = nullptr;
    if (hi - lo > 1) bar = xcd_barrier_post((unsigned*)(F.ws + WS_CTL) + CW_BAR, MISC + 8);
    int ph = 0;
#define PH_ON (lo <= ph && ph < hi)
#define PH_END do { if (PH_ON && ph + 1 < hi) xcd_barrier(bar); ++ph; } while (0)

    float* X = args.out;
    float* XD = (float*)(F.ws + WS_DUMMY);
    float* mod = (float*)(F.ws + WS_MOD);
    bf16* Hb = (bf16*)(F.ws + WS_H); bf16* Ub = (bf16*)(F.ws + WS_U);
    bf16* QDb = (bf16*)(F.ws + WS_QD); bf16* KDb = (bf16*)(F.ws + WS_KD); bf16* Vb = (bf16*)(F.ws + WS_V); bf16* SGb = (bf16*)(F.ws + WS_SG);
    bf16* Yb = (bf16*)(F.ws + WS_Y); bf16* Zb = (bf16*)(F.ws + WS_Z); bf16* Sb = (bf16*)(F.ws + WS_S);
    const float* dec = (const float*)(F.ws + WS_DEC);

    if (PH_ON) REP(1) prologue_phase(F, in);
    PH_END;

    for (int L = 0; L < DEPTH; ++L) {
        const float* mod_t = mod + (size_t)(L * 2 + 0) * BATCH * (3 * D);
        const float* mod_m = mod + (size_t)(L * 2 + 1) * BATCH * (3 * D);
        const float* xin = (L == 0) ? in.x : X;
        const int lp = L >> 1;
        if ((L & 1) == 0) {
            if (PH_ON) REP(2) pool_phase(F, xin, Hb, in.norm_g + (size_t)(L * 2 + 0) * D, mod_t);
            PH_END;
            if (PH_ON) {
                pg8::Gemm g{Hb, (const bf16*)(F.ws + WS_WPOOL) + (size_t)lp * NPG * PG * PG, M, D, PG, D, PG, 1, PG};
                pg8::StaticOrder S; S.init(M, D, F.G, (int)blockIdx.x);
                REP(4) { EpiRes E{xin, rep_ ? X : XD, mod_t + 2 * D, 3 * D, in.pool_scale + (size_t)lp * D};
                pg8::gemm_phase<EpiRes, pg8::StaticOrder, true, true>(F.lds, g, S, E); }
            }
            PH_END;
        } else {
            if (PH_ON) REP(8) norm_phase(F, X, Hb, in.norm_g + (size_t)(L * 2 + 0) * D, mod_t);
            PH_END;
            if (PH_ON) {
                pg8::Gemm g{Hb, (const bf16*)(F.ws + WS_WIN) + (size_t)lp * D * NPROJ, M, NPROJ, D, D, D, 0, 0};
                pg8::StaticOrder S; S.init(M, NPROJ, F.G, (int)blockIdx.x);
                EpiProj E{QDb, KDb, Vb, SGb, (const float*)(F.ws + WS_COS), (const float*)(F.ws + WS_SIN), dec};
                REP(16) pg8::gemm_phase<EpiProj, pg8::StaticOrder, true, true>(F.lds, g, S, E);
            }
            PH_END;
            if (PH_ON) REP(32) s_phase(F, QDb, KDb, Sb, dec);
            PH_END;
            if (PH_ON) REP(64) { if (rep_) chain_phase<0>(F, QDb, KDb, Vb, Sb, Yb, dec); else chain_phase<PROBE_CHAIN_VAR>(F, QDb, KDb, Vb, Sb, (bf16*)XD, dec); }
            PH_END;
            if (PH_ON) REP(128) gn_phase(F, Yb, SGb, Zb);
            PH_END;
            if (PH_ON) {
                pg8::Gemm g{Zb, (const bf16*)(F.ws + WS_WOUT) + (size_t)lp * VD * D, M, D, VD, VD, VD, 0, 0};
                pg8::StaticOrder S; S.init(M, D, F.G, (int)blockIdx.x);
                REP(256) { EpiRes E{X, rep_ ? X : XD, mod_t + 2 * D, 3 * D, nullptr};
                pg8::gemm_phase<EpiRes, pg8::StaticOrder, true, true>(F.lds, g, S, E); }
            }
            PH_END;
        }
        if (PH_ON) REP(8) norm_phase(F, X, Hb, in.norm_g + (size_t)(L * 2 + 1) * D, mod_m);
        PH_END;
        if (PH_ON) {
            pg8::Gemm g{Hb, (const bf16*)(F.ws + WS_W1) + (size_t)L * D * FF, M, FF, D, D, D, 0, 0};
            pg8::StaticOrder S; S.init(M, FF, F.G, (int)blockIdx.x);
            EpiSq E{Ub, FF};
            REP(512) pg8::gemm_phase<EpiSq, pg8::StaticOrder, true, true>(F.lds, g, S, E);
        }
        PH_END;
        if (PH_ON) {
            pg8::Gemm g{Ub, (const bf16*)(F.ws + WS_W2) + (size_t)L * FF * D, M, D, FF, FF, FF, 0, 0};
            pg8::StaticOrder S; S.init(M, D, F.G, (int)blockIdx.x);
#if PROBE_LEAK
            const unsigned long long lk_t0 = __builtin_amdgcn_s_memtime(), lk_r0 = __builtin_amdgcn_s_memrealtime();
#endif
            REP(1024) { EpiRes E{X, rep_ ? X : XD, mod_m + 2 * D, 3 * D, nullptr};
            pg8::gemm_phase<EpiRes, pg8::StaticOrder, true, true>(F.lds, g, S, E); }
#if PROBE_LEAK
            if (L == PROBE_LEAK - 1 && threadIdx.x == 0) { unsigned* dbg = (unsigned*)(F.ws + WS_CTL + 32768);
                const unsigned dt = (unsigned)(__builtin_amdgcn_s_memrealtime() - lk_r0);
                atomicMax(dbg + 0, dt); atomicMax(dbg + 1, 0x7fffffffu - dt); atomicAdd(dbg + 2, dt); }
#endif
        }
        PH_END;
    }
    if (PH_ON) REP(2048) final_norm_phase(F, X, rep_ ? X : XD, in.final_g);
    PH_END;
#if PROBE_LEAK
    if (blockIdx.x == 0 && threadIdx.x == 0) { asm volatile("s_waitcnt vmcnt(0)" ::: "memory"); unsigned* dbg = (unsigned*)(F.ws + WS_CTL + 32768);
        const float tmax = (float)__hip_atomic_load(dbg + 0, RLX_AGENT) * 0.01f, tmin = (float)(0x7fffffffu - __hip_atomic_load(dbg + 1, RLX_AGENT)) * 0.01f;
        X[0] += 8.0f * __builtin_rintf(tmax / 8.0f);
        X[1] += 8.0f * __builtin_rintf(tmin / 8.0f); }
#endif
#undef PH_ON
#undef PH_END
}
constexpr int N_PHASES = 1 + 2 * (5 + 9) + 1;

extern "C" void kernel_launch(void* const* d_in, const int* in_sizes, int n_in, void* d_out, int out_size, void* d_ws, size_t ws_size, hipStream_t stream) {
    static int grid = 0;
    if (grid == 0) {
        if (n_in != 12 || in_sizes[0] != M * D || out_size != M * D || ws_size < WS_END) { fprintf(stderr, "kernel_launch: unexpected shapes (n_in %d, in0 %d, out %d, ws %zu)\n", n_in, n_in > 0 ? in_sizes[0] : -1, out_size, ws_size); grid = -1; return; }
        int dev = 0, cus = 0, per_cu = 0;
        if (hipGetDevice(&dev) != hipSuccess || hipDeviceGetAttribute(&cus, hipDeviceAttributeMultiprocessorCount, dev) != hipSuccess) { grid = -1; return; }
        if (hipFuncSetAttribute((const void*)fwd, hipFuncAttributeMaxDynamicSharedMemorySize, LDS_BYTES) != hipSuccess) { fprintf(stderr, "kernel_launch: hipFuncSetAttribute failed\n"); grid = -1; return; }
        if (hipOccupancyMaxActiveBlocksPerMultiprocessor(&per_cu, (const void*)fwd, NTHR, LDS_BYTES) != hipSuccess || per_cu < 1) fprintf(stderr, "kernel_launch: occupancy query reports %d\n", per_cu);
        (void)hipGetLastError();
        grid = cus;
    }
    if (grid < 0) return;
    if (hipMemsetAsync((char*)d_ws + WS_CTL, 0, CTL_ZERO_BYTES, stream) != hipSuccess) return;
    Args a{};
    for (int i = 0; i < 12; ++i) a.in[i] = (const float*)d_in[i];
    a.out = (float*)d_out; a.ws = (unsigned char*)d_ws;
#if MK_PER_PHASE
    for (int p = 0; p < N_PHASES; ++p) { a.ph_lo = p; a.ph_hi = p + 1; hipLaunchKernelGGL(fwd, dim3(grid), dim3(NTHR), LDS_BYTES, stream, a); }
#else
    a.ph_lo = 0; a.ph_hi = N_PHASES;
    hipLaunchKernelGGL(fwd, dim3(grid), dim3(NTHR), LDS_BYTES, stream, a);
#endif
    const hipError_t le = hipPeekAtLastError();
    if (le != hipSuccess) fprintf(stderr, "kernel_launch: launch failed: %s\n", hipGetErrorName(le));
}
```

```cpp
#include <hip/hip_runtime.h>
#include <cstdio>
#include <cstdint>

#ifndef MK_PER_PHASE
#define MK_PER_PHASE 0
#endif
#define PROBE_DUP 0
#define PROBE_CHAIN_VAR 0
#define PROBE_LEAK 0
#define REP(bit) for (int rep_ = ((PROBE_DUP) & (bit)) ? 0 : 1; rep_ < 2; ++rep_)

namespace pg8 {
#define PG8_LAS __attribute__((address_space(3)))
typedef unsigned short bf16_t;
typedef short bf16x8 __attribute__((ext_vector_type(8)));
typedef float f32x4 __attribute__((ext_vector_type(4)));
typedef unsigned u32x4 __attribute__((ext_vector_type(4)));
constexpr int BM = 256, BK = 64, HALF = 128, HTB = HALF * BK * 2  , STAGE_BYTES = 8 * HTB, NXCD = 8, WGM = 8;

__host__ __device__ __forceinline__ int lds_byte(int r, int c) { const int st = (r >> 4) * 2 + (c >> 5), rr = r & 15, cc = c & 31, ob = rr * 64 + cc * 2; return st * 1024 + (ob ^ (((ob >> 9) & 1) << 5)); }
__host__ __device__ __forceinline__ void stage_rc(int b, int& R, int& C) { const int st = b / 1024, sb = b % 1024, swz = sb ^ (((sb >> 9) & 1) << 5); R = (st >> 1) * 16 + swz / 64; C = (st & 1) * 32 + (swz % 64) / 2; }
__host__ __device__ __forceinline__ int perm32(int rho) { const int n = rho >> 4, i = rho & 15; return 8 * (i >> 2) + 4 * n + (i & 3); }

struct Unit { int pm, pn; };
struct Gemm { const bf16_t* A; const bf16_t* Bt; int M, N, K, lda, ldb, grp_shift, grp_koff; };

struct StaticOrder {
    int nM, nN, nwg, G, c;
    __host__ __device__ void init(int M, int N, int G_, int c_) { nM = M / BM; nN = N / BM; nwg = nM * nN; G = G_; c = c_; }
    __host__ __device__ bool next(int i, Unit& u) const {
        const long L = (long)i * G + c; if (L >= nwg) return false;
        int wgid = (int)L; { const int q = nwg / NXCD, r = nwg % NXCD, xcd = wgid % NXCD, off = wgid / NXCD; wgid = (xcd < r ? xcd * (q + 1) : r * (q + 1) + (xcd - r) * q) + off; }
        const int nig = WGM * nN, gid = wgid / nig, fm = gid * WGM, gsz = (nM - fm) < WGM ? (nM - fm) : WGM;
        u.pm = fm + ((wgid % nig) % gsz); u.pn = (wgid % nig) / gsz; return true;
    }
    __device__ __forceinline__ void a_ready(const Unit&) const {}
    __device__ __forceinline__ void done(const Unit&) const {}
};

__device__ __forceinline__ unsigned cvt_pk_bf16(float lo, float hi) { unsigned r; asm volatile("v_cvt_pk_bf16_f32 %0, %1, %2" : "=v"(r) : "v"(lo), "v"(hi)); return r; }

template <class Epi, class Sched, bool ALIGN_EPI = false, bool SP2 = false>
__device__ __forceinline__ void gemm_phase(PG8_LAS unsigned char* lds, const Gemm g, const Sched& S, const Epi& E) {
    int tid_ = threadIdx.x; asm volatile("" : "+v"(tid_));
    const int tid = tid_, wid = __builtin_amdgcn_readfirstlane(tid >> 6), lane = tid & 63, wr = wid >> 2, wc = wid & 3, fr = lane & 15, fq = lane >> 4;
    const int K = g.K, nt = K / BK;
    unsigned voffA[2], voffB[2];
#pragma unroll
    for (int i = 0; i < 2; ++i) { int R, C; stage_rc(tid * 16 + i * 8192, R, C); const int Rb = Epi::PERM ? ((R & ~31) + perm32(R & 31)) : R;
        voffA[i] = (unsigned)(R * g.lda + C) * 2u; voffB[i] = (unsigned)(Rb * g.ldb + C) * 2u; }
    const size_t kstep = (size_t)(BK * 2);
    const size_t hstepA = (size_t)HALF * g.lda * 2, hstepB = (size_t)HALF * g.ldb * 2;
    const size_t tstepA = 2 * hstepA, tstepB = 2 * hstepB;
    const unsigned ldsw = (unsigned)wid * 1024u;
    const int aoff = lds_byte(wr * 64 + fr, fq * 8), boff = lds_byte(wc * 32 + fr, fq * 8);
#define PG8_APTR(u) ((const char*)g.A + (size_t)(u).pm * tstepA + (size_t)(((u).pn >> g.grp_shift) * g.grp_koff) * 2)
#define PG8_BPTR(u) ((const char*)g.Bt + (size_t)(u).pn * tstepB)
#define PG8_SA(b, h) (((b) * 2 + (h)) * HTB)
#define PG8_SB(b, h) ((4 + (b) * 2 + (h)) * HTB)
#define PG8_STAGE(bufoff, gbase, voff) do { _Pragma("unroll") for (int _i = 0; _i < 2; ++_i) \
        __builtin_amdgcn_global_load_lds((const unsigned*)((const char*)(gbase) + (voff)[_i]), (PG8_LAS unsigned*)(lds + (bufoff) + ldsw + _i * 8192), 16, 0, 0); } while (0)
#define PG8_LDA(dst, b, h) do { _Pragma("unroll") for (int m = 0; m < 4; ++m) _Pragma("unroll") for (int k = 0; k < 2; ++k) dst[m][k] = *(const PG8_LAS bf16x8*)(lds + PG8_SA(b, h) + aoff + m * 2048 + k * 1024); } while (0)
#define PG8_LDB(dst, b, h) do { _Pragma("unroll") for (int n = 0; n < 2; ++n) _Pragma("unroll") for (int k = 0; k < 2; ++k) dst[n][k] = *(const PG8_LAS bf16x8*)(lds + PG8_SB(b, h) + boff + n * 2048 + k * 1024); } while (0)
#define PG8_MMA(ai, bj, At, Bt) do { __builtin_amdgcn_s_setprio(1); _Pragma("unroll") for (int m = 0; m < 4; ++m) _Pragma("unroll") for (int n = 0; n < 2; ++n) _Pragma("unroll") for (int k = 0; k < 2; ++k) \
        acc[ai][bj][m][n] = __builtin_amdgcn_mfma_f32_16x16x32_bf16(Bt[n][k], At[m][k], acc[ai][bj][m][n], 0, 0, 0); __builtin_amdgcn_s_setprio(0); } while (0)
#define PG8_WAIT_V(n) asm volatile("s_waitcnt vmcnt(" #n ")" ::: "memory")
#define PG8_WAIT_L(n) asm volatile("s_waitcnt lgkmcnt(" #n ")" ::: "memory")
#define PG8_BAR __builtin_amdgcn_s_barrier()
#define PG8_SCHED __builtin_amdgcn_sched_barrier(0)
    Unit cur, nxt; int ui = 0;
    if (!S.next(0, cur)) return;
    f32x4 acc[2][2][4][2];
#pragma unroll
    for (int a = 0; a < 2; ++a)
#pragma unroll
        for (int b = 0; b < 2; ++b)
#pragma unroll
            for (int m = 0; m < 4; ++m)
#pragma unroll
                for (int n = 0; n < 2; ++n) acc[a][b][m][n] = (f32x4){0.f, 0.f, 0.f, 0.f};
    bf16x8 At[4][2], B0[2][2], B1[2][2];
    const char* cA = PG8_APTR(cur); const char* cB = PG8_BPTR(cur);
    S.a_ready(cur);
    if constexpr (SP2) {
        PG8_STAGE(PG8_SB(0, 0), cB, voffB); PG8_STAGE(PG8_SB(0, 1), cB + hstepB, voffB); PG8_STAGE(PG8_SA(0, 0), cA, voffA); PG8_STAGE(PG8_SA(0, 1), cA + hstepA, voffA);
        if (wr == 1) PG8_BAR;
        PG8_WAIT_V(2); PG8_BAR;
        PG8_STAGE(PG8_SB(1, 0), cB + kstep, voffB); PG8_STAGE(PG8_SA(1, 0), cA + kstep, voffA); PG8_STAGE(PG8_SB(1, 1), cB + hstepB + kstep, voffB);
        PG8_WAIT_V(6); PG8_BAR;
    } else {
        PG8_STAGE(PG8_SB(0, 0), cB, voffB); PG8_STAGE(PG8_SA(0, 0), cA, voffA); PG8_STAGE(PG8_SB(0, 1), cB + hstepB, voffB); PG8_STAGE(PG8_SA(0, 1), cA + hstepA, voffA);
        if (wr == 1) PG8_BAR;
        PG8_WAIT_V(4); PG8_BAR;
        PG8_STAGE(PG8_SB(1, 0), cB + kstep, voffB); PG8_STAGE(PG8_SA(1, 0), cA + kstep, voffA); PG8_STAGE(PG8_SB(1, 1), cB + hstepB + kstep, voffB);
        PG8_WAIT_V(6); PG8_BAR;
    }
    for (;;) {
        const bool has_next = S.next(ui + 1, nxt);
        const char* nA = has_next ? PG8_APTR(nxt) : cA; const char* nB = has_next ? PG8_BPTR(nxt) : cB;
        for (int t = 0; t < nt; t += 2) {
            const bool last = (t == nt - 2);
            const char* a1 = cA + (size_t)(t + 1) * kstep;
            const char* a2 = last ? nA : cA + (size_t)(t + 2) * kstep; const char* b2 = last ? nB : cB + (size_t)(t + 2) * kstep;
            const char* a3 = a2 + kstep; const char* b3 = b2 + kstep;
            if (last && has_next) S.a_ready(nxt);
            if constexpr (SP2) {
            PG8_LDB(B0, 0, 0); PG8_LDB(B1, 0, 1); PG8_SCHED; PG8_LDA(At, 0, 0); PG8_STAGE(PG8_SA(1, 1), a1 + hstepA, voffA);
            PG8_WAIT_V(8); PG8_WAIT_L(0); PG8_BAR; PG8_MMA(0, 0, At, B0); PG8_MMA(0, 1, At, B1); PG8_BAR; PG8_SCHED;
            PG8_LDA(At, 0, 1); PG8_STAGE(PG8_SB(0, 0), b2, voffB); PG8_STAGE(PG8_SB(0, 1), b2 + hstepB, voffB); PG8_STAGE(PG8_SA(0, 0), a2, voffA);
            PG8_WAIT_V(8); PG8_WAIT_L(0); PG8_BAR; PG8_MMA(1, 0, At, B0); PG8_MMA(1, 1, At, B1); PG8_BAR; PG8_SCHED;
            PG8_LDB(B0, 1, 0); PG8_LDB(B1, 1, 1); PG8_SCHED; PG8_LDA(At, 1, 0); PG8_STAGE(PG8_SA(0, 1), a2 + hstepA, voffA);
            PG8_WAIT_V(8); PG8_WAIT_L(0); PG8_BAR; PG8_MMA(0, 0, At, B0); PG8_MMA(0, 1, At, B1); PG8_BAR; PG8_SCHED;
            PG8_LDA(At, 1, 1); PG8_STAGE(PG8_SB(1, 0), b3, voffB); PG8_STAGE(PG8_SB(1, 1), b3 + hstepB, voffB); PG8_STAGE(PG8_SA(1, 0), a3, voffA);
            PG8_WAIT_V(8); PG8_WAIT_L(0); PG8_BAR; PG8_MMA(1, 0, At, B0); PG8_MMA(1, 1, At, B1); PG8_BAR; PG8_SCHED;
            } else {
            PG8_LDB(B0, 0, 0); PG8_SCHED; PG8_LDA(At, 0, 0); PG8_STAGE(PG8_SA(1, 1), a1 + hstepA, voffA);
            PG8_WAIT_L(8); PG8_BAR; PG8_WAIT_L(0); PG8_MMA(0, 0, At, B0); PG8_BAR; PG8_SCHED;
            PG8_LDB(B1, 0, 1); PG8_STAGE(PG8_SB(0, 0), b2, voffB);
            PG8_BAR; PG8_WAIT_L(0); PG8_MMA(0, 1, At, B1); PG8_BAR;
            PG8_LDA(At, 0, 1); PG8_STAGE(PG8_SA(0, 0), a2, voffA);
            PG8_BAR; PG8_WAIT_L(0); PG8_MMA(1, 0, At, B0); PG8_BAR; PG8_SCHED;
            PG8_STAGE(PG8_SB(0, 1), b2 + hstepB, voffB);
            PG8_WAIT_V(6); PG8_BAR; PG8_MMA(1, 1, At, B1); PG8_BAR;
            PG8_LDB(B0, 1, 0); PG8_SCHED; PG8_LDA(At, 1, 0); PG8_STAGE(PG8_SA(0, 1), a2 + hstepA, voffA);
            PG8_WAIT_L(8); PG8_BAR; PG8_WAIT_L(0); PG8_MMA(0, 0, At, B0); PG8_BAR; PG8_SCHED;
            PG8_LDB(B1, 1, 1); PG8_STAGE(PG8_SB(1, 0), b3, voffB);
            PG8_BAR; PG8_WAIT_L(0); PG8_MMA(0, 1, At, B1); PG8_BAR;
            PG8_LDA(At, 1, 1); PG8_STAGE(PG8_SA(1, 0), a3, voffA);
            PG8_BAR; PG8_WAIT_L(0); PG8_MMA(1, 0, At, B0); PG8_BAR; PG8_SCHED;
            PG8_STAGE(PG8_SB(1, 1), b3 + hstepB, voffB);
            PG8_WAIT_V(6); PG8_BAR; PG8_MMA(1, 1, At, B1); PG8_BAR;
            }
        }
        if constexpr (ALIGN_EPI) { if (wr == 0) PG8_BAR; }
        E(acc, cur, wr, wc, fr, fq);
        if (!has_next) break;
#pragma unroll
        for (int a = 0; a < 2; ++a)
#pragma unroll
            for (int b = 0; b < 2; ++b)
#pragma unroll
                for (int m = 0; m < 4; ++m)
#pragma unroll
                    for (int n = 0; n < 2; ++n) acc[a][b][m][n] = (f32x4){0.f, 0.f, 0.f, 0.f};
        cur = nxt; cA = nA; cB = nB; ++ui;
        if constexpr (ALIGN_EPI) { if (wr == 1) PG8_BAR; }
    }
    PG8_WAIT_V(0);
    if constexpr (!ALIGN_EPI) { if (wr == 0) PG8_BAR; }
    PG8_BAR;
#undef PG8_APTR
#undef PG8_BPTR
#undef PG8_SA
#undef PG8_SB
#undef PG8_STAGE
#undef PG8_LDA
#undef PG8_LDB
#undef PG8_MMA
#undef PG8_WAIT_V
#undef PG8_WAIT_L
#undef PG8_BAR
#undef PG8_SCHED
}
}

constexpr int NWAVES = 8, NTHR = NWAVES * 64;
constexpr int BATCH = 2, SEQ = 4096, D = 2048, DEPTH = 4, M = BATCH * SEQ;
constexpr int NPG = 4, PG = 512;
constexpr int RH = 8, DK = 256, DV = 512, VD = 4096, RC = 128, NCH = SEQ / RC;
constexpr int NPROJ = 2 * D + 2 * VD;
constexpr int FF = 4 * D;
constexpr float EPS = 1e-6f;

constexpr size_t MiB = 1u << 20;
constexpr size_t WS_CTL = 0, CTL_ZERO_BYTES = 64 * 1024;
constexpr size_t WS_MOD = 1 * MiB;
constexpr size_t WS_DEC = 2 * MiB;
constexpr size_t WS_COS = 3 * MiB, WS_SIN = 5 * MiB;
constexpr size_t WS_WPOOL = 8 * MiB;
constexpr size_t WS_WIN = 12 * MiB;
constexpr size_t WS_WOUT = 108 * MiB;
constexpr size_t WS_W1 = 140 * MiB;
constexpr size_t WS_W2 = 268 * MiB;
constexpr size_t WS_H = 396 * MiB;
constexpr size_t WS_U = 428 * MiB;
constexpr size_t WS_QD = 556 * MiB;
constexpr size_t WS_KD = 588 * MiB;
constexpr size_t WS_V = 620 * MiB;
constexpr size_t WS_SG = 684 * MiB;
constexpr size_t WS_Y = 748 * MiB;
constexpr size_t WS_Z = 813 * MiB;
constexpr size_t WS_S = 877 * MiB;
constexpr size_t WS_DUMMY = 893 * MiB;
constexpr size_t WS_END = 958 * MiB;
constexpr size_t Y_SLICE = (size_t)SEQ * 64 + 256;
constexpr int CW_BAR = 4096;

constexpr int RING_BYTES = 131072;
constexpr int LDSCTL_OFF = 8 * 16640, MISC_OFF = LDSCTL_OFF + 320;
constexpr int LDS_BYTES = 147456;

#define GAS __attribute__((address_space(1)))
#define LAS __attribute__((address_space(3)))
typedef unsigned short bf16;
typedef unsigned v4u __attribute__((ext_vector_type(4)));
typedef unsigned v2u __attribute__((ext_vector_type(2)));
typedef float f32x4 __attribute__((ext_vector_type(4)));
typedef float f32x2 __attribute__((ext_vector_type(2)));
typedef short bf16x8 __attribute__((ext_vector_type(8)));
typedef short bf16x4 __attribute__((ext_vector_type(4)));
typedef GAS unsigned gu32;
#define RLX_AGENT __ATOMIC_RELAXED, __HIP_MEMORY_SCOPE_AGENT
__device__ __forceinline__ unsigned f2bf(float f) { unsigned u = __builtin_bit_cast(unsigned, f); return (u + 0x7fffu + ((u >> 16) & 1u)) >> 16; }
__device__ __forceinline__ unsigned pk2(float lo, float hi) { return f2bf(lo) | (f2bf(hi) << 16); }
__device__ __forceinline__ float bf2f(unsigned short b) { return __builtin_bit_cast(float, ((unsigned)b) << 16); }
__device__ __forceinline__ float bflo(unsigned w) { return __builtin_bit_cast(float, w << 16); }
__device__ __forceinline__ float bfhi(unsigned w) { return __builtin_bit_cast(float, w & 0xffff0000u); }

#define XB_TMO      128
#define XB_XCNT(j)  (256  + 64 * (j))
#define XB_XSUB(j)  (1280 + 64 * (j))
#define XB_XGEN(j)  (2304 + 64 * (j))
#define XB_TOP      3328
#define XB_TOPGEN   3392
#define XCD_BAR_WORDS 3456
#define XB_SPIN_CAP (1u << 18)
__device__ __forceinline__ unsigned xb_ld(unsigned* p)              { return __hip_atomic_load(p, __ATOMIC_RELAXED, __HIP_MEMORY_SCOPE_AGENT); }
__device__ __forceinline__ unsigned xb_add(unsigned* p, unsigned v) { return __hip_atomic_fetch_add(p, v, __ATOMIC_RELAXED, __HIP_MEMORY_SCOPE_AGENT); }
__device__ __forceinline__ unsigned xb_xcc_id() { return (unsigned)__builtin_amdgcn_s_getreg((3 << 11) | 20) & 0xFu; }
#define XB_SPIN(cond, bar) do { unsigned _sp = 0; while (cond) { __builtin_amdgcn_s_sleep(1); \
    if ((++_sp & 255u) == 0u) { if (xb_ld(&(bar)[XB_TMO])) break; if (_sp > XB_SPIN_CAP) { atomicAdd(&(bar)[XB_TMO], 1u); break; } } } } while (0)
struct XcdBarrier { unsigned* bar; unsigned x; volatile LAS unsigned* st; };
__device__ __forceinline__ XcdBarrier xcd_barrier_post(unsigned* bar, volatile LAS unsigned* st) {
    XcdBarrier b; b.bar = bar; b.x = xb_xcc_id(); b.st = st;
    if (threadIdx.x == 0) (void)xb_add(&bar[XB_XCNT(b.x)], 1u);
    return b;
}
__device__ __forceinline__ void xcd_barrier_complete(unsigned* bar, unsigned x, unsigned& nloc, unsigned& nx) {
    const unsigned G = gridDim.x * gridDim.y * gridDim.z;
    unsigned sum, cnt, mine, sp = 0u;
    for (;;) {
        sum = 0u; cnt = 0u; mine = 0u;
#pragma unroll
        for (unsigned j = 0; j < 16; ++j) { const unsigned c = xb_ld(&bar[XB_XCNT(j)]); sum += c; cnt += (c > 0u) ? 1u : 0u; mine = (j == x) ? c : mine; }
        if (sum == G) break;
        __builtin_amdgcn_s_sleep(1);
        if ((++sp & 255u) == 0u) { if (xb_ld(&bar[XB_TMO])) break; if (sp > XB_SPIN_CAP) { atomicAdd(&bar[XB_TMO], 1u); break; } }
    }
    nloc = mine > 0u ? mine : 1u; nx = cnt > 0u ? cnt : 1u;
}
__device__ __forceinline__ void xcd_barrier(const XcdBarrier& b) {
    asm volatile("s_waitcnt vmcnt(0)" ::: "memory");
    __syncthreads();
    if (threadIdx.x == 0) {
        unsigned* bar = b.bar;
        __builtin_amdgcn_s_waitcnt(0);
        unsigned nloc = b.st[0], nx = b.st[1];
        if (nloc == 0u) { xcd_barrier_complete(bar, b.x, nloc, nx); b.st[0] = nloc; b.st[1] = nx; }
        const unsigned old = xb_add(&bar[XB_XSUB(b.x)], 1u);
        const unsigned gen = old / nloc;
        if (old + 1u == (gen + 1u) * nloc) {
            __builtin_amdgcn_fence(__ATOMIC_RELEASE, "agent");
            asm volatile("s_waitcnt vmcnt(0)" ::: "memory");
            const unsigned og = xb_add(&bar[XB_TOP], 1u);
            const unsigned tg = og / nx;
            if (og + 1u == (tg + 1u) * nx) xb_add(&bar[XB_TOPGEN], 1u);
            else XB_SPIN(xb_ld(&bar[XB_TOPGEN]) == tg, bar);
            __builtin_amdgcn_fence(__ATOMIC_ACQUIRE, "agent");
            xb_add(&bar[XB_XGEN(b.x)], 1u);
            asm volatile("s_waitcnt vmcnt(0)" ::: "memory");
        } else {
            XB_SPIN(xb_ld(&bar[XB_XGEN(b.x)]) == gen, bar);
            __builtin_amdgcn_fence(__ATOMIC_ACQUIRE, "agent");
            asm volatile("s_waitcnt vmcnt(0)" ::: "memory");
        }
    }
    __syncthreads();
}

struct Frame {
    LAS unsigned char* lds;
    int tid, lane, wave, vcu, G;
    unsigned char* ws;
    __device__ __forceinline__ void refresh() { int t = threadIdx.x; asm volatile("" : "+v"(t)); tid = t; lane = t & 63; wave = __builtin_amdgcn_readfirstlane(t >> 6); }
};
__device__ __forceinline__ float wave_sum(float v) {
#pragma unroll
    for (int o = 1; o < 64; o <<= 1) v += __shfl_xor(v, o);
    return v;
}

using pg8::Unit; using pg8::BM; using pg8::HALF; using pg8::bf16_t; using pg8::u32x4; using pg8::cvt_pk_bf16;
struct EpiRes {
    static constexpr bool PERM = false;
    const float* xin; float* xout; const float* gate; int gstride; const float* ls;
    __device__ __forceinline__ void operator()(const f32x4 (&acc)[2][2][4][2], const Unit& u, int wr, int wc, int fr, int fq) const {
        const int row0 = u.pm * BM + wr * 64 + fr, col0 = u.pn * BM + wc * 32 + 4 * fq;
        const int b = (u.pm * BM) / SEQ;
        f32x4 gv[2][2];
#pragma unroll
        for (int bj = 0; bj < 2; ++bj)
#pragma unroll
            for (int n = 0; n < 2; ++n) { const int c = col0 + bj * HALF + n * 16; f32x4 gg = *(const f32x4*)(gate + (size_t)b * gstride + c); if (ls) gg = gg * *(const f32x4*)(ls + c); gv[bj][n] = gg; }
#pragma unroll
        for (int ai = 0; ai < 2; ++ai)
#pragma unroll
            for (int m = 0; m < 4; ++m) { const size_t off = (size_t)(row0 + ai * HALF + m * 16) * D + col0;
#pragma unroll
                for (int bj = 0; bj < 2; ++bj)
#pragma unroll
                    for (int n = 0; n < 2; ++n) { const f32x4 xi = *(const f32x4*)(xin + off + bj * HALF + n * 16); *(f32x4*)(xout + off + bj * HALF + n * 16) = xi + gv[bj][n] * acc[ai][bj][m][n]; }
                if (m & 1) asm volatile("" ::: "memory"); }
    }
};
struct EpiSq {
    static constexpr bool PERM = true;
    bf16_t* O; int ldc;
    __device__ __forceinline__ void operator()(const f32x4 (&acc)[2][2][4][2], const Unit& u, int wr, int wc, int fr, int fq) const {
        const int row0 = u.pm * BM + wr * 64 + fr, col0 = u.pn * BM + wc * 32 + 8 * fq;
#pragma unroll
        for (int ai = 0; ai < 2; ++ai)
#pragma unroll
            for (int m = 0; m < 4; ++m) { bf16_t* rowp = O + (size_t)(row0 + ai * HALF + m * 16) * ldc + col0;
#pragma unroll
                for (int bj = 0; bj < 2; ++bj) { f32x4 v0 = acc[ai][bj][m][0], v1 = acc[ai][bj][m][1];
#pragma unroll
                    for (int j = 0; j < 4; ++j) { const float a0 = fmaxf(v0[j], 0.f), a1 = fmaxf(v1[j], 0.f); v0[j] = a0 * a0; v1[j] = a1 * a1; }
                    u32x4 w; w.x = cvt_pk_bf16(v0[0], v0[1]); w.y = cvt_pk_bf16(v0[2], v0[3]); w.z = cvt_pk_bf16(v1[0], v1[1]); w.w = cvt_pk_bf16(v1[2], v1[3]);
                    *(u32x4*)(rowp + bj * HALF) = w; } }
    }
};
struct EpiProj {
    static constexpr bool PERM = true;
    bf16_t *QD, *KD, *V, *SG; const float *cosT, *sinT, *dec;
    __device__ __forceinline__ void operator()(const f32x4 (&acc)[2][2][4][2], const Unit& u, int wr, int wc, int fr, int fq) const {
        const int row0 = u.pm * BM + wr * 64 + fr, c0 = wc * 32 + 8 * fq;
        if (u.pn < 16) {
            const int h = u.pn & 7; const bool isk = u.pn >= 8;
            char* base = (char*)(isk ? KD : QD) + (size_t)(8 * h + wc) * 1024 + (fq * 16 + fr) * 16;
            const float* dtab = dec + (isk ? 1024 : 0) + h * RC;
#pragma unroll
            for (int ai = 0; ai < 2; ++ai)
#pragma unroll
                for (int m = 0; m < 4; ++m) { const int r = row0 + ai * HALF + m * 16; const int pos = r & (SEQ - 1); const float dc = dtab[r & (RC - 1)];
#pragma unroll
                    for (int bj = 0; bj < 2; ++bj) { const int pi = (c0 + bj * HALF) >> 1;
                        const f32x4 cs = *(const f32x4*)(cosT + (size_t)pos * 128 + pi), sn = *(const f32x4*)(sinT + (size_t)pos * 128 + pi);
                        const f32x4 v0 = acc[ai][bj][m][0], v1 = acc[ai][bj][m][1];
                        const float o0 = (v0[0] * cs[0] - v0[1] * sn[0]) * dc, o1 = (v0[0] * sn[0] + v0[1] * cs[0]) * dc;
                        const float o2 = (v0[2] * cs[1] - v0[3] * sn[1]) * dc, o3 = (v0[2] * sn[1] + v0[3] * cs[1]) * dc;
                        const float o4 = (v1[0] * cs[2] - v1[1] * sn[2]) * dc, o5 = (v1[0] * sn[2] + v1[1] * cs[2]) * dc;
                        const float o6 = (v1[2] * cs[3] - v1[3] * sn[3]) * dc, o7 = (v1[2] * sn[3] + v1[3] * cs[3]) * dc;
                        u32x4 w; w.x = cvt_pk_bf16(o0, o1); w.y = cvt_pk_bf16(o2, o3); w.z = cvt_pk_bf16(o4, o5); w.w = cvt_pk_bf16(o6, o7);
                        *(u32x4*)(base + (size_t)((r >> 4) * 64 + 4 * bj) * 1024) = w; }
                    if (m & 1) asm volatile("" ::: "memory"); }
        } else {
            const bool isg = u.pn >= 32;
            bf16_t* base = SG + (u.pn - 32) * BM + c0;
            char* vbase = (char*)V + (size_t)((u.pn - 16) * 8 + wc) * 1024 + (fq * 16 + fr) * 16;
#pragma unroll
            for (int ai = 0; ai < 2; ++ai)
#pragma unroll
                for (int m = 0; m < 4; ++m) { const int r = row0 + ai * HALF + m * 16;
#pragma unroll
                    for (int bj = 0; bj < 2; ++bj) { f32x4 v0 = acc[ai][bj][m][0], v1 = acc[ai][bj][m][1];
                        if (isg) {
#pragma unroll
                            for (int j = 0; j < 4; ++j) { v0[j] = v0[j] * __builtin_amdgcn_rcpf(1.0f + __expf(-v0[j])); v1[j] = v1[j] * __builtin_amdgcn_rcpf(1.0f + __expf(-v1[j])); } }
                        u32x4 w; w.x = cvt_pk_bf16(v0[0], v0[1]); w.y = cvt_pk_bf16(v0[2], v0[3]); w.z = cvt_pk_bf16(v1[0], v1[1]); w.w = cvt_pk_bf16(v1[2], v1[3]);
                        if (isg) *(u32x4*)(base + (size_t)r * VD + bj * HALF) = w; else *(u32x4*)(vbase + (size_t)((r >> 4) * 128 + 4 * bj) * 1024) = w; } }
        }
    }
};

__device__ __forceinline__ void p0_transpose_item(const float* W, int K, int N, bf16* WT, LAS float* scr, int item, int lane) {
    const int nblk = N / 64, kb = item / nblk, nb = item % nblk, k0 = 64 * kb, n0 = 64 * nb;
    f32x4 v[16];
#pragma unroll
    for (int i = 0; i < 16; ++i) v[i] = *(const f32x4*)(W + (size_t)(k0 + 4 * i + (lane >> 4)) * N + n0 + 4 * (lane & 15));
#pragma unroll
    for (int i = 0; i < 16; ++i) { LAS float* d = scr + (4 * i + (lane >> 4)) * 65 + 4 * (lane & 15); d[0] = v[i].x; d[1] = v[i].y; d[2] = v[i].z; d[3] = v[i].w; }
    asm volatile("s_waitcnt lgkmcnt(0)" ::: "memory"); __builtin_amdgcn_wave_barrier();
    const int c = lane & 7;
#pragma unroll
    for (int j = 0; j < 8; ++j) { const int n = (lane >> 3) + 8 * j; const LAS float* s = scr + (8 * c) * 65 + n;
        v4u o; o.x = pk2(s[0 * 65], s[1 * 65]); o.y = pk2(s[2 * 65], s[3 * 65]); o.z = pk2(s[4 * 65], s[5 * 65]); o.w = pk2(s[6 * 65], s[7 * 65]);
        *(v4u*)(WT + (size_t)(n0 + n) * K + k0 + 8 * c) = o; }
    asm volatile("s_waitcnt lgkmcnt(0)" ::: "memory"); __builtin_amdgcn_wave_barrier();
}
struct Inputs { const float *x, *c, *ada_w, *ada_b, *norm_g, *pool_w, *pool_scale, *ret_w_in, *ret_w_out, *mlp_w1, *mlp_w2, *final_g; };

__device__ __forceinline__ void prologue_phase(Frame& F, const Inputs& in) {
    F.refresh();
    LAS float* cond = (LAS float*)(F.lds);
    LAS float* red = (LAS float*)(F.lds + 16384);
    for (int i = F.tid; i < BATCH * D; i += NTHR) { const float cv = in.c[i]; cond[i] = cv / (1.0f + expf(-cv)); }
    __syncthreads();
    float* mod = (float*)(F.ws + WS_MOD);
    for (int it = blockIdx.x; it < 8 * 96; it += F.G) {
        const int is = it / 96, col0 = (it % 96) * 64;
        const float* W = in.ada_w + (size_t)is * D * (3 * D) + col0;
        const int rsub = F.lane >> 4, cq = F.lane & 15, d0 = F.wave * 256;
        f32x4 a0 = {0.f, 0.f, 0.f, 0.f}, a1 = {0.f, 0.f, 0.f, 0.f};
#pragma unroll 16
        for (int rr = 0; rr < 256; rr += 4) { const int d = d0 + rr + rsub; const f32x4 wv = *(const f32x4*)(W + (size_t)d * (3 * D) + 4 * cq);
            const float c0 = cond[d], c1 = cond[D + d]; a0 += wv * c0; a1 += wv * c1; }
#pragma unroll
        for (int j = 0; j < 4; ++j) { a0[j] += __shfl_xor(a0[j], 16); a0[j] += __shfl_xor(a0[j], 32); a1[j] += __shfl_xor(a1[j], 16); a1[j] += __shfl_xor(a1[j], 32); }
        if (rsub == 0) { *(LAS f32x4*)(red + (F.wave * 2 + 0) * 64 + 4 * cq) = a0; *(LAS f32x4*)(red + (F.wave * 2 + 1) * 64 + 4 * cq) = a1; }
        __syncthreads();
        if (F.tid < 128) { const int b = F.tid >> 6, cc = F.tid & 63; float s = 0.f;
#pragma unroll
            for (int w = 0; w < 8; ++w) s += red[(w * 2 + b) * 64 + cc];
            mod[((size_t)is * BATCH + b) * (3 * D) + col0 + cc] = s + in.ada_b[(size_t)is * (3 * D) + col0 + cc]; }
        __syncthreads();
    }
    {
        LAS float* scr = (LAS float*)(F.lds + F.wave * 16640);
        const int gw = F.vcu * NWAVES + F.wave, NGW = F.G * NWAVES;
        constexpr int I_P = (PG / 64) * (PG / 64), I_IN = (D / 64) * (NPROJ / 64), I_OUT = (VD / 64) * (D / 64), I_1 = (D / 64) * (FF / 64), I_2 = (FF / 64) * (D / 64);
        constexpr int N_P = 8 * I_P, N_IN = 2 * I_IN, N_OUT = 2 * I_OUT, N_1 = 4 * I_1, N_2 = 4 * I_2;
        for (int it = gw; it < N_P + N_IN + N_OUT + N_1 + N_2; it += NGW) {
            int r = it;
            if (r < N_P) { const int mt = r / I_P; p0_transpose_item(in.pool_w + (size_t)mt * PG * PG, PG, PG, (bf16*)(F.ws + WS_WPOOL) + (size_t)mt * PG * PG, scr, r % I_P, F.lane); continue; } r -= N_P;
            if (r < N_IN) { const int mt = r / I_IN; p0_transpose_item(in.ret_w_in + (size_t)mt * D * NPROJ, D, NPROJ, (bf16*)(F.ws + WS_WIN) + (size_t)mt * D * NPROJ, scr, r % I_IN, F.lane); continue; } r -= N_IN;
            if (r < N_OUT) { const int mt = r / I_OUT; p0_transpose_item(in.ret_w_out + (size_t)mt * VD * D, VD, D, (bf16*)(F.ws + WS_WOUT) + (size_t)mt * VD * D, scr, r % I_OUT, F.lane); continue; } r -= N_OUT;
            if (r < N_1) { const int mt = r / I_1; p0_transpose_item(in.mlp_w1 + (size_t)mt * D * FF, D, FF, (bf16*)(F.ws + WS_W1) + (size_t)mt * D * FF, scr, r % I_1, F.lane); continue; } r -= N_1;
            { const int mt = r / I_2; p0_transpose_item(in.mlp_w2 + (size_t)mt * FF * D, FF, D, (bf16*)(F.ws + WS_W2) + (size_t)mt * FF * D, scr, r % I_2, F.lane); }
        }
    }
    {
        float* cosT = (float*)(F.ws + WS_COS); float* sinT = (float*)(F.ws + WS_SIN);
        const int gt = blockIdx.x * NTHR + F.tid, NGT = F.G * NTHR;
        for (int e = gt; e < SEQ * 128; e += NGT) {
            const int pos = e >> 7, i = e & 127;
            double inv = 1.0, bp = 0.9305720409296989792906463164991290590767;
#pragma unroll
            for (int bit = 0; bit < 7; ++bit) { if ((i >> bit) & 1) inv *= bp; bp *= bp; }
            const double ang = (double)pos * inv;
            const double kq = __builtin_rint(ang * 0.6366197723675814);
            double r = __builtin_fma(-kq, 1.5707963267948966, ang); r = __builtin_fma(-kq, 6.123233995736766e-17, r);
            const double r2 = r * r;
            double sp = -1.0 / 1307674368000.0;
            sp = sp * r2 + 1.0 / 6227020800.0; sp = sp * r2 - 1.0 / 39916800.0; sp = sp * r2 + 1.0 / 362880.0; sp = sp * r2 - 1.0 / 5040.0; sp = sp * r2 + 1.0 / 120.0; sp = sp * r2 - 1.0 / 6.0; sp = sp * r2 + 1.0;
            const double sr = sp * r;
            double cp = 1.0 / 20922789888000.0;
            cp = cp * r2 - 1.0 / 87178291200.0; cp = cp * r2 + 1.0 / 479001600.0; cp = cp * r2 - 1.0 / 3628800.0; cp = cp * r2 + 1.0 / 40320.0; cp = cp * r2 - 1.0 / 720.0; cp = cp * r2 + 1.0 / 24.0; cp = cp * r2 - 0.5; cp = cp * r2 + 1.0;
            const int q = ((int)kq) & 3;
            const double sv = (q == 0) ? sr : (q == 1) ? cp : (q == 2) ? -sr : -cp;
            const double cv = (q == 0) ? cp : (q == 1) ? -sr : (q == 2) ? -cp : sr;
            cosT[e] = (float)cv; sinT[e] = (float)sv;
        }
        if (blockIdx.x == 0 && F.tid < RH) {
            float* dec = (float*)(F.ws + WS_DEC); const int h = F.tid;
            const double gam = 1.0 - __builtin_ldexp(1.0, -5 - h);
            double p = 1.0;
            for (int i = 0; i < RC; ++i) { p *= gam; dec[h * RC + i] = (float)p; }
            const double g128 = p;
            double q = 1.0 / 16.0;
            for (int j = RC - 1; j >= 0; --j) { dec[1024 + h * RC + j] = (float)q; q *= gam; }
            dec[2048 + h] = (float)(1.0 / g128);
            dec[2056 + h] = (float)g128;
        }
    }
}

__device__ __forceinline__ void norm_phase(Frame& F, const float* x, bf16* H, const float* g, const float* modp) {
    F.refresh();
    const int gw = F.vcu * NWAVES + F.wave, NGW = F.G * NWAVES;
    for (int r4 = gw; r4 < M / 4; r4 += NGW) {
        const int b = (4 * r4) / SEQ; const float* mp = modp + (size_t)b * (3 * D);
        f32x4 Gc[8], Sc[8];
#pragma unroll
        for (int j = 0; j < 8; ++j) { const int c = 4 * F.lane + 256 * j; const f32x4 gg = *(const f32x4*)(g + c), sc = *(const f32x4*)(mp + D + c); Gc[j] = gg * (sc + 1.0f); Sc[j] = *(const f32x4*)(mp + c); }
        for (int rr = 0; rr < 4; ++rr) {
            const size_t row = (size_t)4 * r4 + rr; const f32x4* xr = (const f32x4*)(x + row * D) + F.lane;
            f32x4 v[8]; float ss = 0.f;
#pragma unroll
            for (int j = 0; j < 8; ++j) { v[j] = xr[64 * j]; ss += (v[j].x * v[j].x + v[j].y * v[j].y) + (v[j].z * v[j].z + v[j].w * v[j].w); }
            const float rstd = 1.0f / sqrtf(wave_sum(ss) * (1.0f / D) + EPS);
            v2u* o = (v2u*)(H + row * D) + F.lane;
#pragma unroll
            for (int j = 0; j < 8; ++j) { const f32x4 hh = v[j] * rstd * Gc[j] + Sc[j]; v2u w; w.x = pk2(hh.x, hh.y); w.y = pk2(hh.z, hh.w); o[64 * j] = w; }
        }
    }
}
__device__ __forceinline__ void final_norm_phase(Frame& F, const float* x, float* out, const float* g) {
    F.refresh();
    const int gw = F.vcu * NWAVES + F.wave, NGW = F.G * NWAVES;
    for (int row = gw; row < M; row += NGW) {
        const f32x4* xr = (const f32x4*)(x + (size_t)row * D) + F.lane;
        f32x4 v[8]; float ss = 0.f;
#pragma unroll
        for (int j = 0; j < 8; ++j) { v[j] = xr[64 * j]; ss += (v[j].x * v[j].x + v[j].y * v[j].y) + (v[j].z * v[j].z + v[j].w * v[j].w); }
        const float rstd = 1.0f / sqrtf(wave_sum(ss) * (1.0f / D) + EPS);
        f32x4* o = (f32x4*)(out + (size_t)row * D) + F.lane;
#pragma unroll
        for (int j = 0; j < 8; ++j) o[64 * j] = v[j] * rstd * *(const f32x4*)(g + 4 * F.lane + 256 * j);
    }
}

__device__ __forceinline__ void pool_phase(Frame& F, const float* x, bf16* P, const float* g, const float* modp) {
    F.refresh();
    LAS float* tile = (LAS float*)(F.lds);
    LAS float* rst = (LAS float*)(F.lds + 47 * 512 * 4);
    for (int blk = blockIdx.x; blk < M / 32; blk += F.G) {
        const int t0 = 32 * blk, b = t0 / SEQ, tb = t0 & (SEQ - 1), halo = (tb == 0) ? 0 : 15;
        const float* mp = modp + (size_t)b * (3 * D);
        for (int tr = 15 - halo + F.wave; tr < 47; tr += 8) {
            const f32x4* xr = (const f32x4*)(x + (size_t)(t0 - 15 + tr) * D) + F.lane; float ss = 0.f;
#pragma unroll
            for (int j = 0; j < 8; ++j) { const f32x4 v = xr[64 * j]; ss += (v.x * v.x + v.y * v.y) + (v.z * v.z + v.w * v.w); }
            ss = wave_sum(ss);
            if (F.lane == 0) rst[tr] = 1.0f / sqrtf(ss * (1.0f / D) + EPS);
        }
        __syncthreads();
        for (int gi = 0; gi < NPG; ++gi) {
            const int c4 = F.tid & 127, cg = gi * PG + 4 * c4;
            const f32x4 Gc = *(const f32x4*)(g + cg) * (*(const f32x4*)(mp + D + cg) + 1.0f), Sc = *(const f32x4*)(mp + cg);
            for (int tr = 15 - halo + (F.tid >> 7); tr < 47; tr += 4) {
                const f32x4 xv = *(const f32x4*)(x + (size_t)(t0 - 15 + tr) * D + cg);
                *(LAS f32x4*)(tile + tr * 512 + 4 * c4) = xv * rst[tr] * Gc + Sc;
            }
            __syncthreads();
            const int w = 2 << gi, cp = F.tid & 255, i0 = (F.tid >> 8) * 16;
            f32x2 s = {0.f, 0.f};
            {
                const int tpos = tb + i0, nwin = (tpos + 1 < w) ? tpos + 1 : w;
                for (int q = 0; q < nwin; ++q) s += *(const LAS f32x2*)(tile + (i0 + 15 - q) * 512 + 2 * cp);
            }
            for (int k = 0; k < 16; ++k) {
                const int i = i0 + k, tr = i + 15, tpos = tb + i;
                if (k > 0) { s += *(const LAS f32x2*)(tile + tr * 512 + 2 * cp); if (tpos >= w) s -= *(const LAS f32x2*)(tile + (tr - w) * 512 + 2 * cp); }
                const int nwin = (tpos + 1 < w) ? tpos + 1 : w;
                const f32x2 hv = *(const LAS f32x2*)(tile + tr * 512 + 2 * cp);
                const float inv = 1.0f / (float)nwin;
                *(unsigned*)(P + (size_t)(t0 + i) * D + gi * PG + 2 * cp) = pk2(s.x * inv - hv.x, s.y * inv - hv.y);
            }
            __syncthreads();
        }
    }
}

__device__ __forceinline__ void s_phase(Frame& F, const bf16* QD, const bf16* KD, bf16* S, const float* dec) {
    F.refresh();
    const int g = F.lane >> 4, l15 = F.lane & 15;
    for (int pair = blockIdx.x; pair < 256; pair += F.G) {
        for (int half = 0; half < 2; ++half) {
            const int item = 2 * pair + half, itile = half ? 7 - F.wave : F.wave;
            const int bh = item >> 5, c = item & 31, b = bh >> 3, h = bh & 7, r0 = b * SEQ + RC * c;
            const float ssc = dec[2048 + h];
            bf16x8 qf[8];
            const char* qblk = (const char*)QD + (size_t)(((r0 >> 4) + itile) * 64 + 8 * h) * 1024 + F.lane * 16;
#pragma unroll
            for (int ks = 0; ks < 8; ++ks) qf[ks] = *(const bf16x8*)(qblk + ks * 1024);
            const int i = 16 * itile + l15;
            char* sblk = (char*)S + (size_t)item * (RC * RC * 2) + (size_t)(itile * 4) * 1024 + ((g >> 1) * 16 + l15) * 16 + 8 * (g & 1);
            for (int jt = 0; jt < 8; ++jt) {
                f32x4 acc = {0.f, 0.f, 0.f, 0.f};
                if (jt <= itile) {
                    const char* kblk = (const char*)KD + (size_t)(((r0 >> 4) + jt) * 64 + 8 * h) * 1024 + F.lane * 16;
#pragma unroll
                    for (int ks = 0; ks < 8; ++ks) { const bf16x8 kf = *(const bf16x8*)(kblk + ks * 1024); acc = __builtin_amdgcn_mfma_f32_16x16x32_bf16(kf, qf[ks], acc, 0, 0, 0); }
                }
                const int jb = 16 * jt + 4 * g;
                float o[4];
#pragma unroll
                for (int rg = 0; rg < 4; ++rg) o[rg] = (jb + rg <= i) ? acc[rg] * ssc : 0.f;
                v2u w; w.x = pk2(o[0], o[1]); w.y = pk2(o[2], o[3]);
                *(v2u*)(sblk + (jt >> 1) * 1024 + (jt & 1) * 512) = w;
            }
        }
    }
}

__device__ __forceinline__ bf16x8 tr_frag(unsigned base, int k0, int c0, int rowb, int lane) {
    const int g = lane >> 4, q = (lane & 15) >> 2, p = lane & 3;
    const unsigned a0 = base + (unsigned)((k0 + 8 * g + q) * rowb + (c0 + 4 * p) * 2), a1 = a0 + 4u * (unsigned)rowb;
    bf16x4 lo, hi;
    asm volatile("ds_read_b64_tr_b16 %0, %2\n\tds_read_b64_tr_b16 %1, %3\n\ts_waitcnt lgkmcnt(0)" : "=&v"(lo), "=&v"(hi) : "v"(a0), "v"(a1) : "memory");
    return __builtin_shufflevector(lo, hi, 0, 1, 2, 3, 4, 5, 6, 7);
}
constexpr int CH_KS_BYTES = 8192;
constexpr int CH_VBYTES = 8192, CH_VIMG = 8 * CH_KS_BYTES;
constexpr int CH_SROW = 528, CH_SBYTES = 32 * CH_SROW, CH_SIMG = CH_VIMG + 2 * CH_VBYTES;
constexpr int CH_YT = CH_SIMG + 2 * CH_SBYTES;
static_assert(CH_YT + 8 * 1024 <= RING_BYTES, "chain LDS map");
#define TRT_ASM "ds_read_b64_tr_b16 %0, %16 offset:0\n\tds_read_b64_tr_b16 %1, %16 offset:64\n\tds_read_b64_tr_b16 %2, %16 offset:512\n\tds_read_b64_tr_b16 %3, %16 offset:576\n\tds_read_b64_tr_b16 %4, %16 offset:2048\n\tds_read_b64_tr_b16 %5, %16 offset:2112\n\tds_read_b64_tr_b16 %6, %16 offset:2560\n\tds_read_b64_tr_b16 %7, %16 offset:2624\n\tds_read_b64_tr_b16 %8, %16 offset:4096\n\tds_read_b64_tr_b16 %9, %16 offset:4160\n\tds_read_b64_tr_b16 %10, %16 offset:4608\n\tds_read_b64_tr_b16 %11, %16 offset:4672\n\tds_read_b64_tr_b16 %12, %16 offset:6144\n\tds_read_b64_tr_b16 %13, %16 offset:6208\n\tds_read_b64_tr_b16 %14, %16 offset:6656\n\tds_read_b64_tr_b16 %15, %16 offset:6720\n\ts_waitcnt lgkmcnt(0)"
#define SB_ASM0 "ds_read_b128 %0, %8 offset:0\n\tds_read_b128 %1, %8 offset:8448\n\tds_read_b128 %2, %8 offset:64\n\tds_read_b128 %3, %8 offset:8512\n\tds_read_b128 %4, %8 offset:128\n\tds_read_b128 %5, %8 offset:8576\n\tds_read_b128 %6, %8 offset:192\n\tds_read_b128 %7, %8 offset:8640"
#define SB_ASM1 "ds_read_b128 %0, %8 offset:256\n\tds_read_b128 %1, %8 offset:8704\n\tds_read_b128 %2, %8 offset:320\n\tds_read_b128 %3, %8 offset:8768\n\tds_read_b128 %4, %8 offset:384\n\tds_read_b128 %5, %8 offset:8832\n\tds_read_b128 %6, %8 offset:448\n\tds_read_b128 %7, %8 offset:8896\n\ts_waitcnt lgkmcnt(0)"
#define TR16(ASM, r, addr) asm volatile(ASM : "=&v"(r[0]), "=&v"(r[1]), "=&v"(r[2]), "=&v"(r[3]), "=&v"(r[4]), "=&v"(r[5]), "=&v"(r[6]), "=&v"(r[7]), "=&v"(r[8]), "=&v"(r[9]), "=&v"(r[10]), "=&v"(r[11]), \
        "=&v"(r[12]), "=&v"(r[13]), "=&v"(r[14]), "=&v"(r[15]) : "v"(addr) : "memory")
template <int VAR>
__device__ __forceinline__ void chain_phase(Frame& F, const bf16* QD, const bf16* KD, const bf16* V, const bf16* S, bf16* Y, const float* dec) {
    F.refresh();
    const int g = F.lane >> 4, l15 = F.lane & 15, w = F.wave, q4 = l15 >> 2, p4 = F.lane & 3;
    const unsigned lbase = (unsigned)(size_t)F.lds;
    const unsigned tr_lane = (unsigned)((g >> 1) * 1024 + ((p4 >> 1) * 16 + 8 * (g & 1) + q4) * 16 + 8 * (p4 & 1));
    const unsigned ktr_addr = lbase + (unsigned)(w * CH_KS_BYTES) + tr_lane;
    const unsigned vtr_off = (unsigned)CH_VIMG + tr_lane;
    const int nks = (w >> 1) + 1;
    for (int it = F.vcu; it < 256; it += F.G) {
        const int bh = it >> 4, es = it & 15, b = bh >> 3, h = bh & 7;
        const float cd = dec[2056 + h];
        f32x4 st[2][2];
#pragma unroll
        for (int a = 0; a < 2; ++a)
#pragma unroll
            for (int n = 0; n < 2; ++n) st[a][n] = (f32x4){0.f, 0.f, 0.f, 0.f};
        const char* ksrc = (const char*)KD + (size_t)((b * SEQ / 16) * 64 + 8 * h + w) * 1024 + F.lane * 16;
        const char* vsrc = (const char*)V + (size_t)((b * SEQ / 16 + w) * 128 + 16 * h + es) * 1024 + F.lane * 16;
        const char* qsrc = (const char*)QD + (size_t)((b * SEQ / 16 + w) * 64 + 8 * h) * 1024 + F.lane * 16;
        const char* ssrc = (const char*)S + (size_t)bh * NCH * (RC * RC * 2) + (size_t)(w * 4) * 1024 + F.lane * 16;
        char* ydst = (char*)Y + (size_t)it * Y_SLICE + (16 * w) * 64 + F.lane * 16;
        v4u kreg[8]; v4u vreg; bf16x8 qf[8], sf[4];
#pragma unroll
        for (int n = 0; n < 8; ++n) kreg[n] = *(const v4u*)(ksrc + (size_t)n * 65536);
        vreg = *(const v4u*)vsrc;
#pragma unroll
        for (int ks = 0; ks < 8; ++ks) qf[ks] = *(const bf16x8*)(qsrc + ks * 1024);
#pragma unroll
        for (int ks = 0; ks < 4; ++ks) if (ks < nks) sf[ks] = *(const bf16x8*)(ssrc + ks * 1024);
        for (int c = 0; c < NCH; ++c) {
            const int buf = c & 1;
#pragma unroll
            for (int n = 0; n < 8; ++n) *(LAS v4u*)(F.lds + w * CH_KS_BYTES + n * 1024 + F.lane * 16) = kreg[n];
            *(LAS v4u*)(F.lds + CH_VIMG + buf * CH_VBYTES + w * 1024 + F.lane * 16) = vreg;
#pragma unroll
            for (int a = 0; a < 2; ++a)
#pragma unroll
                for (int n = 0; n < 2; ++n) { v2u pk; pk.x = pk2(st[a][n][0], st[a][n][1]); pk.y = pk2(st[a][n][2], st[a][n][3]);
                    *(LAS v2u*)(F.lds + CH_SIMG + buf * CH_SBYTES + (16 * n + l15) * CH_SROW + (32 * w + 16 * a + 4 * g) * 2) = pk; }
            if (c + 1 < NCH && VAR != 3) {
#pragma unroll
                for (int n = 0; n < 8; ++n) kreg[n] = *(const v4u*)(ksrc + (size_t)((c + 1) * 8 + n) * 65536);
                vreg = *(const v4u*)(vsrc + (size_t)(c + 1) * 8 * 131072);
            }
            __syncthreads();
            const unsigned sa = lbase + (unsigned)(CH_SIMG + buf * CH_SBYTES + l15 * CH_SROW + g * 16);
            bf16x8 sb[8];
            asm volatile(SB_ASM0 : "=&v"(sb[0]), "=&v"(sb[1]), "=&v"(sb[2]), "=&v"(sb[3]), "=&v"(sb[4]), "=&v"(sb[5]), "=&v"(sb[6]), "=&v"(sb[7]) : "v"(sa) : "memory");
            bf16x4 tv[16]; { const unsigned va = lbase + vtr_off + (unsigned)(buf * CH_VBYTES); TR16(TRT_ASM, tv, va); }
            asm volatile("" : "+v"(sb[0]), "+v"(sb[1]), "+v"(sb[2]), "+v"(sb[3]), "+v"(sb[4]), "+v"(sb[5]), "+v"(sb[6]), "+v"(sb[7]));
            bf16x8 bv[4][2];
#pragma unroll
            for (int ks = 0; ks < 4; ++ks)
#pragma unroll
                for (int n = 0; n < 2; ++n) bv[ks][n] = __builtin_shufflevector(tv[(ks * 2 + n) * 2], tv[(ks * 2 + n) * 2 + 1], 0, 1, 2, 3, 4, 5, 6, 7);
            f32x4 acc[2] = {{0.f, 0.f, 0.f, 0.f}, {0.f, 0.f, 0.f, 0.f}};
#pragma unroll
            for (int ks = 0; ks < 4; ++ks) if (ks < nks) {
#pragma unroll
                for (int n = 0; n < 2; ++n) acc[n] = __builtin_amdgcn_mfma_f32_16x16x32_bf16(sf[ks], bv[ks][n], acc[n], 0, 0, 0); }
#pragma unroll
            for (int ks = 0; ks < 4; ++ks)
#pragma unroll
                for (int n = 0; n < 2; ++n) acc[n] = __builtin_amdgcn_mfma_f32_16x16x32_bf16(qf[ks], sb[ks * 2 + n], acc[n], 0, 0, 0);
            bf16x8 sc[8];
            asm volatile(SB_ASM1 : "=&v"(sc[0]), "=&v"(sc[1]), "=&v"(sc[2]), "=&v"(sc[3]), "=&v"(sc[4]), "=&v"(sc[5]), "=&v"(sc[6]), "=&v"(sc[7]) : "v"(sa) : "memory");
#pragma unroll
            for (int ks = 0; ks < 4; ++ks)
#pragma unroll
                for (int n = 0; n < 2; ++n) acc[n] = __builtin_amdgcn_mfma_f32_16x16x32_bf16(qf[4 + ks], sc[ks * 2 + n], acc[n], 0, 0, 0);
            if (c + 1 < NCH && VAR != 2) {
#pragma unroll
                for (int ks = 0; ks < 8; ++ks) qf[ks] = *(const bf16x8*)(qsrc + (size_t)(c + 1) * 8 * 65536 + ks * 1024);
#pragma unroll
                for (int ks = 0; ks < 4; ++ks) if (ks < nks) sf[ks] = *(const bf16x8*)(ssrc + (size_t)(c + 1) * (RC * RC * 2) + ks * 1024);
            }
#pragma unroll
            for (int a = 0; a < 2; ++a)
#pragma unroll
                for (int n = 0; n < 2; ++n) st[a][n] = st[a][n] * cd;
            bf16x4 tk[16]; TR16(TRT_ASM, tk, ktr_addr);
#pragma unroll
            for (int ks = 0; ks < 4; ++ks)
#pragma unroll
                for (int a = 0; a < 2; ++a) { const bf16x8 ak = __builtin_shufflevector(tk[(ks * 2 + a) * 2], tk[(ks * 2 + a) * 2 + 1], 0, 1, 2, 3, 4, 5, 6, 7);
#pragma unroll
                    for (int n = 0; n < 2; ++n) st[a][n] = __builtin_amdgcn_mfma_f32_16x16x32_bf16(ak, bv[ks][n], st[a][n], 0, 0, 0); }
            LAS unsigned char* yt = F.lds + CH_YT + w * 1024;
#pragma unroll
            for (int n = 0; n < 2; ++n)
#pragma unroll
                for (int rg = 0; rg < 4; ++rg) *(LAS bf16*)(yt + (4 * g + rg) * 64 + (16 * n + l15) * 2) = (bf16)f2bf(acc[n][rg]);
            asm volatile("s_waitcnt lgkmcnt(0)" ::: "memory"); __builtin_amdgcn_wave_barrier();
            { const v4u yv = *(const LAS v4u*)(yt + F.lane * 16); asm volatile("" ::: "memory");
              if (VAR != 1 || yv.x == 0x12345678u) *(v4u*)(ydst + (size_t)c * (RC * 64)) = yv; }
        }
        __syncthreads();
    }
}
__device__ __forceinline__ void gn_phase(Frame& F, const bf16* Y, const bf16* SG, bf16* Z) {
    F.refresh();
    const int gw = F.vcu * NWAVES + F.wave, NGW = F.G * NWAVES;
    for (int blk = gw; blk < BATCH * RH * (SEQ / 32); blk += NGW) {
        const int bh = blk / (SEQ / 32), s0 = (blk % (SEQ / 32)) * 32, b = bh >> 3, h = bh & 7;
        const char* yp = (const char*)Y + (size_t)(bh * 16 + (F.lane >> 2)) * Y_SLICE + (size_t)s0 * 64 + (F.lane & 3) * 16;
        const size_t off0 = (size_t)(b * SEQ + s0) * VD + h * DV + 8 * F.lane;
#pragma unroll 4
        for (int rr = 0; rr < 32; ++rr) {
            const v4u yw = *(const v4u*)(yp + rr * 64), gwv = *(const v4u*)(SG + off0 + (size_t)rr * VD);
            float y[8] = {bflo(yw.x), bfhi(yw.x), bflo(yw.y), bfhi(yw.y), bflo(yw.z), bfhi(yw.z), bflo(yw.w), bfhi(yw.w)};
            const float sg[8] = {bflo(gwv.x), bfhi(gwv.x), bflo(gwv.y), bfhi(gwv.y), bflo(gwv.z), bfhi(gwv.z), bflo(gwv.w), bfhi(gwv.w)};
            float sm = 0.f;
#pragma unroll
            for (int j = 0; j < 8; ++j) sm += y[j];
            const float mu = wave_sum(sm) * (1.0f / DV); float q = 0.f;
#pragma unroll
            for (int j = 0; j < 8; ++j) { y[j] -= mu; q += y[j] * y[j]; }
            const float rstd = 1.0f / sqrtf(wave_sum(q) * (1.0f / DV) + EPS);
            v4u o; o.x = pk2(sg[0] * y[0] * rstd, sg[1] * y[1] * rstd); o.y = pk2(sg[2] * y[2] * rstd, sg[3] * y[3] * rstd);
            o.z = pk2(sg[4] * y[4] * rstd, sg[5] * y[5] * rstd); o.w = pk2(sg[6] * y[6] * rstd, sg[7] * y[7] * rstd);
            *(v4u*)(Z + off0 + (size_t)rr * VD) = o;
        }
    }
}

struct Args { const float* in[12]; float* out; unsigned char* ws; int ph_lo, ph_hi; };
__global__ void __launch_bounds__(NTHR, 2) fwd(Args args) {
    extern __shared__ __attribute__((aligned(16))) unsigned char lds[];
    Frame F;
    F.lds = (LAS unsigned char*)lds;
    F.tid = threadIdx.x; F.lane = F.tid & 63; F.wave = __builtin_amdgcn_readfirstlane(F.tid >> 6);
    F.G = gridDim.x; { const int bx = blockIdx.x; F.vcu = (F.G % 8 == 0) ? (bx % 8) * (F.G / 8) + bx / 8 : bx; }
    F.ws = args.ws;
    Inputs in; in.x = args.in[0]; in.c = args.in[1]; in.ada_w = args.in[2]; in.ada_b = args.in[3]; in.norm_g = args.in[4]; in.pool_w = args.in[5]; in.pool_scale = args.in[6];
    in.ret_w_in = args.in[7]; in.ret_w_out = args.in[8]; in.mlp_w1 = args.in[9]; in.mlp_w2 = args.in[10]; in.final_g = args.in[11];
    volatile LAS unsigned* MISC = (volatile LAS unsigned*)(F.lds + MISC_OFF);
    for (int u = F.tid; u < (LDS_BYTES - LDSCTL_OFF) / 4; u += NTHR) ((LAS unsigned*)(F.lds + LDSCTL_OFF))[u] = 0u;
    __syncthreads();
    const int lo = args.ph_lo, hi = args.ph_hi;
    XcdBarrier bar; bar.bar = (unsigned*)(F.ws + WS_CTL) + CW_BAR; bar.x = 0; bar.st = nullptr;
    if (hi - lo > 1) bar = xcd_barrier_post((unsigned*)(F.ws + WS_CTL) + CW_BAR, MISC + 8);
    int ph = 0;
#define PH_ON (lo <= ph && ph < hi)
#define PH_END do { if (PH_ON && ph + 1 < hi) xcd_barrier(bar); ++ph; } while (0)

    float* X = args.out;
    float* XD = (float*)(F.ws + WS_DUMMY);
    float* mod = (float*)(F.ws + WS_MOD);
    bf16* Hb = (bf16*)(F.ws + WS_H); bf16* Ub = (bf16*)(F.ws + WS_U);
    bf16* QDb = (bf16*)(F.ws + WS_QD); bf16* KDb = (bf16*)(F.ws + WS_KD); bf16* Vb = (bf16*)(F.ws + WS_V); bf16* SGb = (bf16*)(F.ws + WS_SG);
    bf16* Yb = (bf16*)(F.ws + WS_Y); bf16* Zb = (bf16*)(F.ws + WS_Z); bf16* Sb = (bf16*)(F.ws + WS_S);
    const float* dec = (const float*)(F.ws + WS_DEC);

    if (PH_ON) REP(1) prologue_phase(F, in);
    PH_END;

    for (int L = 0; L < DEPTH; ++L) {
        const float* mod_t = mod + (size_t)(L * 2 + 0) * BATCH * (3 * D);
        const float* mod_m = mod + (size_t)(L * 2 + 1) * BATCH * (3 * D);
        const float* xin = (L == 0) ? in.x : X;
        const int lp = L >> 1;
        if ((L & 1) == 0) {
            if (PH_ON) REP(2) pool_phase(F, xin, Hb, in.norm_g + (size_t)(L * 2 + 0) * D, mod_t);
            PH_END;
            if (PH_ON) {
                pg8::Gemm g{Hb, (const bf16*)(F.ws + WS_WPOOL) + (size_t)lp * NPG * PG * PG, M, D, PG, D, PG, 1, PG};
                pg8::StaticOrder S; S.init(M, D, F.G, (int)blockIdx.x);
                REP(4) { EpiRes E{xin, rep_ ? X : XD, mod_t + 2 * D, 3 * D, in.pool_scale + (size_t)lp * D};
                pg8::gemm_phase<EpiRes, pg8::StaticOrder, true, true>(F.lds, g, S, E); }
            }
            PH_END;
        } else {
            if (PH_ON) REP(8) norm_phase(F, X, Hb, in.norm_g + (size_t)(L * 2 + 0) * D, mod_t);
            PH_END;
            if (PH_ON) {
                pg8::Gemm g{Hb, (const bf16*)(F.ws + WS_WIN) + (size_t)lp * D * NPROJ, M, NPROJ, D, D, D, 0, 0};
                pg8::StaticOrder S; S.init(M, NPROJ, F.G, (int)blockIdx.x);
                EpiProj E{QDb, KDb, Vb, SGb, (const float*)(F.ws + WS_COS), (const float*)(F.ws + WS_SIN), dec};
                REP(16) pg8::gemm_phase<EpiProj, pg8::StaticOrder, true, true>(F.lds, g, S, E);
            }
            PH_END;
            if (PH_ON) REP(32) s_phase(F, QDb, KDb, Sb, dec);
            PH_END;
            if (PH_ON) REP(64) { if (rep_) chain_phase<0>(F, QDb, KDb, Vb, Sb, Yb, dec); else chain_phase<PROBE_CHAIN_VAR>(F, QDb, KDb, Vb, Sb, (bf16*)XD, dec); }
            PH_END;
            if (PH_ON) REP(128) gn_phase(F, Yb, SGb, Zb);
            PH_END;
            if (PH_ON) {
                pg8::Gemm g{Zb, (const bf16*)(F.ws + WS_WOUT) + (size_t)lp * VD * D, M, D, VD, VD, VD, 0, 0};
                pg8::StaticOrder S; S.init(M, D, F.G, (int)blockIdx.x);
                REP(256) { EpiRes E{X, rep_ ? X : XD, mod_t + 2 * D, 3 * D, nullptr};
                pg8::gemm_phase<EpiRes, pg8::StaticOrder, true, true>(F.lds, g, S, E); }
            }
            PH_END;
        }
        if (PH_ON) REP(8) norm_phase(F, X, Hb, in.norm_g + (size_t)(L * 2 + 1) * D, mod_m);
        PH_END;
        if (PH_ON) {
            pg8::Gemm g{Hb, (const bf16*)(F.ws + WS_W1) + (size_t)L * D * FF, M, FF, D, D, D, 0, 0};
            pg8::StaticOrder S; S.init(M, FF, F.G, (int)blockIdx.x);
            EpiSq E{Ub, FF};
            REP(512) pg8::gemm_phase<EpiSq, pg8::StaticOrder, true, true>(F.lds, g, S, E);
        }
        PH_END;
        if (PH_ON) {
            pg8::Gemm g{Ub, (const bf16*)(F.ws + WS_W2) + (size_t)L * FF * D, M, D, FF, FF, FF, 0, 0};
            pg8::StaticOrder S; S.init(M, D, F.G, (int)blockIdx.x);
#if PROBE_LEAK
            const unsigned long long lk_t0 = __builtin_amdgcn_s_memtime(), lk_r0 = __builtin_amdgcn_s_memrealtime();
#endif
            REP(1024) { EpiRes E{X, rep_ ? X : XD, mod_m + 2 * D, 3 * D, nullptr};
            pg8::gemm_phase<EpiRes, pg8::StaticOrder, true, true>(F.lds, g, S, E); }
#if PROBE_LEAK
            if (L == PROBE_LEAK - 1 && threadIdx.x == 0) { unsigned* dbg = (unsigned*)(F.ws + WS_CTL + 32768);
                const unsigned dt = (unsigned)(__builtin_amdgcn_s_memrealtime() - lk_r0);
                atomicMax(dbg + 0, dt); atomicMax(dbg + 1, 0x7fffffffu - dt); atomicAdd(dbg + 2, dt); }
#endif
        }
        PH_END;
    }
    if (PH_ON) REP(2048) final_norm_phase(F, X, rep_ ? X : XD, in.final_g);
    PH_END;
#if PROBE_LEAK
    if (blockIdx.x == 0 && threadIdx.x == 0) { asm volatile("s_waitcnt vmcnt(0)" ::: "memory"); unsigned* dbg = (unsigned*)(F.ws + WS_CTL + 32768);
        const float tmax = (float)__hip_atomic_load(dbg + 0, RLX_AGENT) * 0.01f, tmin = (float)(0x7fffffffu - __hip_atomic_load(dbg + 1, RLX_AGENT)) * 0.01f;
        X[0] += 8.0f * __builtin_rintf(tmax / 8.0f);
        X[1] += 8.0f * __builtin_rintf(tmin / 8.0f); }
#endif
#undef PH_ON
#undef PH_END
}
constexpr int N_PHASES = 1 + 2 * (5 + 9) + 1;

extern "C" void kernel_launch(void* const* d_in, const int* in_sizes, int n_in, void* d_out, int out_size, void* d_ws, size_t ws_size, hipStream_t stream) {
    static int grid = 0;
    if (grid == 0) {
        if (n_in != 12 || in_sizes[0] != M * D || out_size != M * D || ws_size < WS_END) { fprintf(stderr, "kernel_launch: unexpected shapes (n_in %d, in0 %d, out %d, ws %zu)\n", n_in, n_in > 0 ? in_sizes[0] : -1, out_size, ws_size); grid = -1; return; }
        int dev = 0, cus = 0, per_cu = 0;
        if (hipGetDevice(&dev) != hipSuccess || hipDeviceGetAttribute(&cus, hipDeviceAttributeMultiprocessorCount, dev) != hipSuccess) { grid = -1; return; }
        if (hipFuncSetAttribute((const void*)fwd, hipFuncAttributeMaxDynamicSharedMemorySize, LDS_BYTES) != hipSuccess) { fprintf(stderr, "kernel_launch: hipFuncSetAttribute failed\n"); grid = -1; return; }
        if (hipOccupancyMaxActiveBlocksPerMultiprocessor(&per_cu, (const void*)fwd, NTHR, LDS_BYTES) != hipSuccess || per_cu < 1) fprintf(stderr, "kernel_launch: occupancy query reports %d\n", per_cu);
        (void)hipGetLastError();
        grid = cus;
    }
    if (grid < 0) return;
    if (hipMemsetAsync((char*)d_ws + WS_CTL, 0, CTL_ZERO_BYTES, stream) != hipSuccess) return;
    Args a{};
    for (int i = 0; i < 12; ++i) a.in[i] = (const float*)d_in[i];
    a.out = (float*)d_out; a.ws = (unsigned char*)d_ws;
#if MK_PER_PHASE
    for (int p = 0; p < N_PHASES; ++p) { a.ph_lo = p; a.ph_hi = p + 1; hipLaunchKernelGGL(fwd, dim3(grid), dim3(NTHR), LDS_BYTES, stream, a); }
#else
    a.ph_lo = 0; a.ph_hi = N_PHASES;
    hipLaunchKernelGGL(fwd, dim3(grid), dim3(NTHR), LDS_BYTES, stream, a);
#endif
    const hipError_t le = hipPeekAtLastError();
    if (le != hipSuccess) fprintf(stderr, "kernel_launch: launch failed: %s\n", hipGetErrorName(le));
}
```
